# Optimizing an MI355X kernel written in HIP

```python
import jax, jax.numpy as jnp
from jax import lax
import numpy as np

D_MODEL = 2048
BATCH = 4
SEQ = 2048
DEPTH = 2

RET_HEADS = 8
RET_HEAD_DIM = D_MODEL // 16
RET_WIDTH = RET_HEADS * RET_HEAD_DIM
RET_CHUNK = 128
ROPE_BASE = 10000.0
SB_HEADS = 8
SB_HEAD_DIM = D_MODEL // 16
SB_WIDTH = SB_HEADS * SB_HEAD_DIM
SB_BLOCK = 128
IN_WIDTH = 4 * RET_WIDTH + 3 * SB_WIDTH
N_BRANCHES = 2
D_FF = 11 * D_MODEL // 4
N_EXPERTS = 8
TOP_K = 2
D_FF_EXPERT = 7 * D_MODEL // 2
MOE_BLOCK = 256
N_DENSE = (DEPTH + 1) // 2
N_MOE = DEPTH // 2
PLE_DIM = 256
DEEPNORM_ALPHA = (2 * DEPTH) ** 0.25
DEEPNORM_BETA = (8 * DEPTH) ** -0.25
LN_EPS = 1e-5

kernel_name = "hybrid_retention_stickbreaking_moe_deepnorm"


def layer_norm(x, g, b):
    xf = x.astype(jnp.float32)
    mu = jnp.mean(xf, axis=-1, keepdims=True)
    xc = xf - mu
    var = jnp.mean(xc * xc, axis=-1, keepdims=True)
    y = xc * lax.rsqrt(var + LN_EPS) * g.astype(jnp.float32) + b.astype(jnp.float32)
    return y.astype(x.dtype)


def head_norm(o):
    mu = jnp.mean(o, axis=-1, keepdims=True)
    oc = o - mu
    var = jnp.mean(oc * oc, axis=-1, keepdims=True)
    return oc * lax.rsqrt(var + LN_EPS)


def rotary(t, pos):
    half = t.shape[-1] // 2
    inv = ROPE_BASE ** (-jnp.arange(half, dtype=jnp.float32) / half)
    ang = pos[:, None] * inv[None, :]
    cos = jnp.cos(ang)[None, :, None, :]
    sin = jnp.sin(ang)[None, :, None, :]
    t1, t2 = t[..., :half], t[..., half:]
    return jnp.concatenate([t1 * cos - t2 * sin, t1 * sin + t2 * cos], axis=-1)


def retention(q, k, v):
    B, S, H, d = q.shape
    dv = v.shape[-1]
    C = RET_CHUNK
    NC = S // C
    gamma = 1.0 - jnp.exp2(-5.0 - jnp.arange(H, dtype=jnp.float32))
    lg = jnp.log(gamma)
    idx = jnp.arange(C, dtype=jnp.float32)
    diff = idx[:, None] - idx[None, :]
    causal = diff >= 0
    decay = jnp.where(causal[None], jnp.exp(jnp.where(causal, diff, 0.0)[None] * lg[:, None, None]), 0.0)
    xi = jnp.exp((idx + 1.0)[None, :] * lg[:, None])
    zeta = jnp.exp((C - 1.0 - idx)[None, :] * lg[:, None])
    chunk_decay = jnp.exp(C * lg)

    def to_chunks(t):
        return t.reshape(B, NC, C, H, t.shape[-1]).transpose(1, 0, 3, 2, 4)

    def step(R, qkv):
        qc, kc, vc = qkv
        inner = jnp.einsum('bhnd,bhmd->bhnm', qc, kc) * decay[None]
        o = (jnp.einsum('bhnm,bhme->bhne', inner, vc)
             + jnp.einsum('bhnd,bhde->bhne', qc, R) * xi[None, :, :, None])
        R = (R * chunk_decay[None, :, None, None]
             + jnp.einsum('bhmd,bhme->bhde', kc * zeta[None, :, :, None], vc))
        return R, o

    R0 = jnp.zeros((B, H, d, dv), jnp.float32)
    _, o = lax.scan(step, R0, (to_chunks(q), to_chunks(k), to_chunks(v)))
    return o.transpose(1, 0, 3, 2, 4).reshape(B, S, H, dv)


def stick_breaking(q, k, v):
    B, S, H, d = q.shape
    scale = d ** -0.5
    outs = []
    for t0 in range(0, S, SB_BLOCK):
        L = t0 + SB_BLOCK
        qb, kp, vp = q[:, t0:L], k[:, :L], v[:, :L]
        z = jnp.einsum('bqhd,bkhd->bhqk', qb, kp) * scale
        mask = jnp.arange(L)[None, :] < (t0 + jnp.arange(SB_BLOCK))[:, None]
        log_fail = jnp.where(mask, jax.nn.log_sigmoid(-z), 0.0)
        later = lax.cumsum(log_fail, axis=3, reverse=True) - log_fail
        w = jnp.where(mask, jnp.exp(jax.nn.log_sigmoid(z) + later), 0.0)
        outs.append(jnp.einsum('bhqk,bkhd->bqhd', w, vp))
    return jnp.concatenate(outs, axis=1)


def token_mixer(x, w_in, w_br_ret, w_br_sb, w_gate, b_gate, w_o):
    B, S, D = x.shape
    h = x @ w_in
    cuts = [RET_WIDTH, 2 * RET_WIDTH, 3 * RET_WIDTH, 4 * RET_WIDTH,
            4 * RET_WIDTH + SB_WIDTH, 4 * RET_WIDTH + 2 * SB_WIDTH]
    rq, rk, rv, rg, sq, sk, sv = jnp.split(h, cuts, axis=-1)
    f32 = jnp.float32
    pos = jnp.arange(S, dtype=f32)

    def ret_heads(t):
        return t.reshape(B, S, RET_HEADS, RET_HEAD_DIM).astype(f32)

    def sb_heads(t):
        return t.reshape(B, S, SB_HEADS, SB_HEAD_DIM).astype(f32)

    q_r = rotary(ret_heads(rq), pos)
    k_r = rotary(ret_heads(rk), pos) * (RET_HEAD_DIM ** -0.5)
    o_ret = head_norm(retention(q_r, k_r, ret_heads(rv))).reshape(B, S, RET_WIDTH)
    o_ret = o_ret.astype(x.dtype) * jax.nn.silu(rg)
    o_sb = stick_breaking(sb_heads(sq), sb_heads(sk), sb_heads(sv)).reshape(B, S, SB_WIDTH).astype(x.dtype)
    gates = jax.nn.sigmoid(x @ w_gate + b_gate)
    g_ret, g_sb = jnp.split(gates, N_BRANCHES, axis=-1)
    merged = g_ret * (o_ret @ w_br_ret) + g_sb * (o_sb @ w_br_sb)
    return merged @ w_o


def swiglu(x, w1, w3, w2):
    return (jax.nn.silu(x @ w1) * (x @ w3)) @ w2


def moe_swiglu(x, w_router, w1, w3, w2):
    B, S, D = x.shape
    N = B * S
    NK = N * TOP_K
    M = MOE_BLOCK
    NB = -(-NK // M) + N_EXPERTS
    P = NB * M
    xf = x.reshape(N, D)
    logits = (xf @ w_router).astype(jnp.float32)
    top_v, top_i = lax.top_k(logits, TOP_K)
    gate = jax.nn.softmax(top_v, axis=-1)
    e_flat = top_i.reshape(NK).astype(jnp.int32)
    tok_flat = jnp.repeat(jnp.arange(N, dtype=jnp.int32), TOP_K)
    g_flat = gate.reshape(NK)
    order = jnp.argsort(e_flat, stable=True)
    se, stok, sg = e_flat[order], tok_flat[order], g_flat[order]
    counts = jax.ops.segment_sum(jnp.ones_like(e_flat), e_flat, num_segments=N_EXPERTS)
    start = jnp.cumsum(counts) - counts
    padded = (counts + M - 1) // M * M
    pad_end = jnp.cumsum(padded)
    pad_off = pad_end - padded
    dest = pad_off[se] + (jnp.arange(NK, dtype=jnp.int32) - start[se])
    buf_tok = jnp.full((P,), N, jnp.int32).at[dest].set(stok)
    buf_gate = jnp.zeros((P,), jnp.float32).at[dest].set(sg)
    block_e = jnp.clip(jnp.searchsorted(pad_end, jnp.arange(NB, dtype=jnp.int32) * M, side='right'),
                       0, N_EXPERTS - 1)
    xpad = jnp.concatenate([xf, jnp.zeros((1, D), x.dtype)], axis=0)
    xb = xpad[buf_tok].reshape(NB, M, D)

    def expert_block(args):
        xblk, e = args
        return (jax.nn.silu(xblk @ w1[e]) * (xblk @ w3[e])) @ w2[e]

    yb = lax.map(expert_block, (xb, block_e)).reshape(P, D)
    out = jnp.zeros((N + 1, D), x.dtype).at[buf_tok].add(yb * buf_gate[:, None].astype(x.dtype))
    return out[:N].reshape(B, S, D)


def setup_inputs(seed: int = 0) -> dict:
    key = jax.random.key(seed)
    ks = jax.random.split(key, 24)
    f32 = jnp.float32

    def nrm(k, shape, scale):
        return jax.random.normal(k, shape, f32) * scale

    D = D_MODEL
    return {
        "x": nrm(ks[0], (BATCH, SEQ, D), 1.0),
        "p": nrm(ks[1], (DEPTH, BATCH, SEQ, PLE_DIM), 1.0),
        "w_in": nrm(ks[2], (DEPTH, D, IN_WIDTH), D ** -0.5),
        "w_br_ret": nrm(ks[3], (DEPTH, RET_WIDTH, D), RET_WIDTH ** -0.5),
        "w_br_sb": nrm(ks[4], (DEPTH, SB_WIDTH, D), SB_WIDTH ** -0.5),
        "w_gate": nrm(ks[5], (DEPTH, D, N_BRANCHES * D), D ** -0.5),
        "b_gate": nrm(ks[6], (DEPTH, N_BRANCHES * D), 0.01),
        "w_o": nrm(ks[7], (DEPTH, D, D), D ** -0.5 * DEEPNORM_BETA),
        "ln1_g": 1.0 + nrm(ks[8], (DEPTH, D), 0.02),
        "ln1_b": nrm(ks[9], (DEPTH, D), 0.02),
        "ffn_w1": nrm(ks[10], (N_DENSE, D, D_FF), D ** -0.5),
        "ffn_w3": nrm(ks[11], (N_DENSE, D, D_FF), D ** -0.5),
        "ffn_w2": nrm(ks[12], (N_DENSE, D_FF, D), D_FF ** -0.5 * DEEPNORM_BETA),
        "moe_router": nrm(ks[13], (N_MOE, D, N_EXPERTS), D ** -0.5),
        "moe_w1": nrm(ks[14], (N_MOE, N_EXPERTS, D, D_FF_EXPERT), D ** -0.5),
        "moe_w3": nrm(ks[15], (N_MOE, N_EXPERTS, D, D_FF_EXPERT), D ** -0.5),
        "moe_w2": nrm(ks[16], (N_MOE, N_EXPERTS, D_FF_EXPERT, D), D_FF_EXPERT ** -0.5 * DEEPNORM_BETA),
        "ple_w": nrm(ks[17], (DEPTH, PLE_DIM, D), PLE_DIM ** -0.5),
        "ple_gate_w": nrm(ks[18], (DEPTH, D, D), D ** -0.5),
        "ln2_g": 1.0 + nrm(ks[19], (DEPTH, D), 0.02),
        "ln2_b": nrm(ks[20], (DEPTH, D), 0.02),
    }


def reference(x, p, w_in, w_br_ret, w_br_sb, w_gate, b_gate, w_o, ln1_g, ln1_b,
              ffn_w1, ffn_w3, ffn_w2, moe_router, moe_w1, moe_w3, moe_w2,
              ple_w, ple_gate_w, ln2_g, ln2_b):
    for i in range(DEPTH):
        mix = token_mixer(x, w_in[i], w_br_ret[i], w_br_sb[i], w_gate[i], b_gate[i], w_o[i])
        x = layer_norm(DEEPNORM_ALPHA * x + mix, ln1_g[i], ln1_b[i])
        if i % 2 == 0:
            f = swiglu(x, ffn_w1[i // 2], ffn_w3[i // 2], ffn_w2[i // 2])
        else:
            f = moe_swiglu(x, moe_router[i // 2], moe_w1[i // 2], moe_w3[i // 2], moe_w2[i // 2])
        ple = jax.nn.sigmoid(x @ ple_gate_w[i]) * (p[i] @ ple_w[i])
        x = layer_norm(DEEPNORM_ALPHA * x + f + ple, ln2_g[i], ln2_b[i])
    return x
```

```cpp
#include <hip/hip_runtime.h>
#include <cstdio>
#include <cstdint>

typedef unsigned short bf16;
typedef short bf16x8 __attribute__((ext_vector_type(8)));
typedef float f32x4 __attribute__((ext_vector_type(4)));
typedef float f32x16 __attribute__((ext_vector_type(16)));
typedef unsigned u32x4 __attribute__((ext_vector_type(4)));
typedef unsigned u32x2 __attribute__((ext_vector_type(2)));

constexpr int NB_ = 4, S_ = 2048, D_ = 2048, NTOK = NB_ * S_, DEPTH = 2;
constexpr int NH = 8, HD = 128, RW = 1024, INW = 7168, DFF = 5632, NE = 8, DFFE = 7168, PLED = 256;
constexpr int MOE_P = 18432;
constexpr float ALPHA = 1.4142135623730951f;
constexpr float LN_EPS = 1e-5f;
constexpr float QK_SCALE = 0.08838834764831845f;

constexpr size_t MiB = 1ull << 20;
constexpr size_t WS_CTL   = 0;
constexpr size_t WS_ROT   = 1 * MiB;
constexpr size_t WS_XB    = 2 * MiB;
constexpr size_t WS_PB    = WS_XB + 32 * MiB;
constexpr size_t WS_X1    = WS_PB + 8 * MiB;
constexpr size_t WS_X1B   = WS_X1 + 64 * MiB;
constexpr size_t WS_X2    = WS_X1B + 32 * MiB;
constexpr size_t WS_PLE   = WS_X2 + 64 * MiB;
constexpr size_t WS_PW    = WS_PLE + 64 * MiB;
constexpr size_t WS_Y     = WS_PW + 64 * MiB;
constexpr size_t WS_T1    = WS_Y;
constexpr size_t WS_MOE   = WS_Y + 64 * MiB;
constexpr size_t WS_MIX   = WS_MOE + 1 * MiB;
constexpr size_t WS_H5    = WS_MIX;
constexpr size_t WS_VT    = WS_H5 + 80 * MiB;
constexpr size_t WS_GATES = WS_VT + 32 * MiB;
constexpr size_t WS_O     = WS_GATES + 64 * MiB;
constexpr size_t WS_MERGED= WS_O + 32 * MiB;
constexpr size_t WS_HMID  = WS_MIX;
constexpr size_t WS_XS    = WS_MIX + 252 * MiB;
constexpr size_t WS_YE    = WS_XS + 72 * MiB;
constexpr size_t WS_ACT_END = WS_YE + 72 * MiB;
static_assert(WS_MERGED + 32 * MiB <= WS_XS, "mixer buffers inside the HMID overlay region");
constexpr size_t MO_TOPE = 0, MO_TOPG = 65536, MO_POS = 131072, MO_ROWTOK = 196608, MO_ROWGATE = 294912, MO_BLKE = 393216, MO_META = 397312;

#define DI __device__ __forceinline__
#define LAS __attribute__((address_space(3)))
DI unsigned f2bf(float f) { unsigned u = __builtin_bit_cast(unsigned, f); return (u + 0x7fffu + ((u >> 16) & 1u)) >> 16; }
DI float bf2f(bf16 b) { return __builtin_bit_cast(float, ((unsigned)b) << 16); }
DI float wave_sum(float v) {
#pragma unroll
    for (int o = 1; o < 64; o <<= 1) v += __shfl_xor(v, o);
    return v;
}

DI void sincos_small(double r, double& s, double& c) {
    const double r2 = r * r;
    s = r * (1.0 + r2 * (-1.0 / 6 + r2 * (1.0 / 120 + r2 * (-1.0 / 5040 + r2 * (1.0 / 362880 + r2 * (-1.0 / 39916800 + r2 * (1.0 / 6227020800.0 + r2 * (-1.0 / 1307674368000.0))))))));
    c = 1.0 + r2 * (-0.5 + r2 * (1.0 / 24 + r2 * (-1.0 / 720 + r2 * (1.0 / 40320 + r2 * (-1.0 / 3628800 + r2 * (1.0 / 479001600.0 + r2 * (-1.0 / 87178291200.0 + r2 * (1.0 / 20922789888000.0))))))));
}
DI void bf8_to_f32(const u32x4 w, f32x4& lo, f32x4& hi) {
    lo[0] = __builtin_bit_cast(float, w.x << 16); lo[1] = __builtin_bit_cast(float, w.x & 0xffff0000u); lo[2] = __builtin_bit_cast(float, w.y << 16); lo[3] = __builtin_bit_cast(float, w.y & 0xffff0000u);
    hi[0] = __builtin_bit_cast(float, w.z << 16); hi[1] = __builtin_bit_cast(float, w.z & 0xffff0000u); hi[2] = __builtin_bit_cast(float, w.w << 16); hi[3] = __builtin_bit_cast(float, w.w & 0xffff0000u);
}
template <bool ROUTE, bool COMBINE>
DI void ln_row(int row, int lane, const bf16* __restrict__ Yb, const float* __restrict__ g, const float* __restrict__ bta, float* __restrict__ X, bf16* __restrict__ XB, unsigned char* __restrict__ XB8,
               const LAS float* wT, int* __restrict__ tope, float* __restrict__ topg,
               const bf16* __restrict__ X1B, const bf16* __restrict__ YE, const int* __restrict__ pos, const bf16* __restrict__ PLEB) {
    f32x4 v[8]; float s = 0.f;
    if (!COMBINE) {
        const bf16* yr = Yb + (size_t)row * D_ + 8 * lane;
#pragma unroll
        for (int j = 0; j < 4; ++j) bf8_to_f32(*(const u32x4*)(yr + 512 * j), v[2 * j], v[2 * j + 1]);
    } else {
        const int p0 = pos[row * 2], p1 = pos[row * 2 + 1]; const float g0 = topg[row * 2], g1 = topg[row * 2 + 1];
        const bf16* YE1 = YE + (size_t)MOE_P * D_;
#pragma unroll
        for (int j = 0; j < 4; ++j) { const int c = 8 * lane + 512 * j;
            f32x4 xa, xb, pa, pb, a0, a1, b0, b1, c0, c1, d0, d1;
            bf8_to_f32(*(const u32x4*)(X1B + (size_t)row * D_ + c), xa, xb); bf8_to_f32(*(const u32x4*)(PLEB + (size_t)row * D_ + c), pa, pb);
            bf8_to_f32(*(const u32x4*)(YE + (size_t)p0 * D_ + c), a0, a1); bf8_to_f32(*(const u32x4*)(YE1 + (size_t)p0 * D_ + c), b0, b1);
            bf8_to_f32(*(const u32x4*)(YE + (size_t)p1 * D_ + c), c0, c1); bf8_to_f32(*(const u32x4*)(YE1 + (size_t)p1 * D_ + c), d0, d1);
            v[2 * j] = (ALPHA * xa + (g0 * (a0 + b0) + g1 * (c0 + d0))) + pa; v[2 * j + 1] = (ALPHA * xb + (g0 * (a1 + b1) + g1 * (c1 + d1))) + pb; }
    }
#pragma unroll
    for (int j = 0; j < 8; ++j) s += (v[j].x + v[j].y) + (v[j].z + v[j].w);
    const float mean = wave_sum(s) * (1.0f / D_); float s2 = 0.f;
#pragma unroll
    for (int j = 0; j < 8; ++j) { v[j] = v[j] - mean; s2 += (v[j].x * v[j].x + v[j].y * v[j].y) + (v[j].z * v[j].z + v[j].w * v[j].w); }
    const float rstd = 1.0f / sqrtf(wave_sum(s2) * (1.0f / D_) + LN_EPS);
    float lg0 = 0.f, lg1 = 0.f, lg2 = 0.f, lg3 = 0.f, lg4 = 0.f, lg5 = 0.f, lg6 = 0.f, lg7 = 0.f;
#pragma unroll
    for (int j = 0; j < 4; ++j) {
        const int c = 8 * lane + 512 * j;
        const f32x4 oa = v[2 * j] * rstd * *(const f32x4*)(g + c) + *(const f32x4*)(bta + c), ob = v[2 * j + 1] * rstd * *(const f32x4*)(g + c + 4) + *(const f32x4*)(bta + c + 4);
        if (X) { *(f32x4*)(X + (size_t)row * D_ + c) = oa; *(f32x4*)(X + (size_t)row * D_ + c + 4) = ob; }
        if (XB) { u32x4 w; w.x = f2bf(oa.x) | (f2bf(oa.y) << 16); w.y = f2bf(oa.z) | (f2bf(oa.w) << 16); w.z = f2bf(ob.x) | (f2bf(ob.y) << 16); w.w = f2bf(ob.z) | (f2bf(ob.w) << 16);
            *(u32x4*)(XB + (size_t)row * D_ + c) = w; }
        if (XB8) { const f32x4 sa = oa * 16.f, sb = ob * 16.f;
            int w0 = __builtin_amdgcn_cvt_pk_fp8_f32(__builtin_amdgcn_fmed3f(sa.x, -448.f, 448.f), __builtin_amdgcn_fmed3f(sa.y, -448.f, 448.f), 0, false);
            w0 = __builtin_amdgcn_cvt_pk_fp8_f32(__builtin_amdgcn_fmed3f(sa.z, -448.f, 448.f), __builtin_amdgcn_fmed3f(sa.w, -448.f, 448.f), w0, true);
            int w1 = __builtin_amdgcn_cvt_pk_fp8_f32(__builtin_amdgcn_fmed3f(sb.x, -448.f, 448.f), __builtin_amdgcn_fmed3f(sb.y, -448.f, 448.f), 0, false);
            w1 = __builtin_amdgcn_cvt_pk_fp8_f32(__builtin_amdgcn_fmed3f(sb.z, -448.f, 448.f), __builtin_amdgcn_fmed3f(sb.w, -448.f, 448.f), w1, true);
            *(u32x2*)(XB8 + (size_t)row * D_ + c) = (u32x2){(unsigned)w0, (unsigned)w1}; }
        if (ROUTE) { v[2 * j] = oa; v[2 * j + 1] = ob; }
    }
    if (ROUTE) {
#pragma unroll 1
        for (int j = 0; j < 8; ++j) {
            const f32x4 o = v[0]; const LAS float* wp = wT + (j & 1) * 1024 + ((j >> 1) * 64 + lane) * 4;
            const f32x4 w0 = *(const LAS f32x4*)(wp), w1 = *(const LAS f32x4*)(wp + 2048), w2 = *(const LAS f32x4*)(wp + 2 * 2048), w3 = *(const LAS f32x4*)(wp + 3 * 2048);
            const f32x4 w4 = *(const LAS f32x4*)(wp + 4 * 2048), w5 = *(const LAS f32x4*)(wp + 5 * 2048), w6 = *(const LAS f32x4*)(wp + 6 * 2048), w7 = *(const LAS f32x4*)(wp + 7 * 2048);
            lg0 += (o[0] * w0[0] + o[1] * w0[1]) + (o[2] * w0[2] + o[3] * w0[3]); lg1 += (o[0] * w1[0] + o[1] * w1[1]) + (o[2] * w1[2] + o[3] * w1[3]);
            lg2 += (o[0] * w2[0] + o[1] * w2[1]) + (o[2] * w2[2] + o[3] * w2[3]); lg3 += (o[0] * w3[0] + o[1] * w3[1]) + (o[2] * w3[2] + o[3] * w3[3]);
            lg4 += (o[0] * w4[0] + o[1] * w4[1]) + (o[2] * w4[2] + o[3] * w4[3]); lg5 += (o[0] * w5[0] + o[1] * w5[1]) + (o[2] * w5[2] + o[3] * w5[3]);
            lg6 += (o[0] * w6[0] + o[1] * w6[1]) + (o[2] * w6[2] + o[3] * w6[3]); lg7 += (o[0] * w7[0] + o[1] * w7[1]) + (o[2] * w7[2] + o[3] * w7[3]);
#pragma unroll
            for (int jj = 0; jj < 7; ++jj) v[jj] = v[jj + 1];
        }
        float lg[8] = {wave_sum(lg0), wave_sum(lg1), wave_sum(lg2), wave_sum(lg3), wave_sum(lg4), wave_sum(lg5), wave_sum(lg6), wave_sum(lg7)};
        if (lane == 0) {
            int i0 = 0; float v0 = lg[0];
#pragma unroll
            for (int e = 1; e < 8; ++e) if (lg[e] > v0) { v0 = lg[e]; i0 = e; }
            int i1 = -1; float v1 = -3.0e38f;
#pragma unroll
            for (int e = 0; e < 8; ++e) if (e != i0 && lg[e] > v1) { v1 = lg[e]; i1 = e; }
            const float e1 = expf(v1 - v0), g0 = 1.0f / (1.0f + e1), g1 = e1 / (1.0f + e1);
            tope[row * 2] = i0; tope[row * 2 + 1] = i1; topg[row * 2] = g0; topg[row * 2 + 1] = g1;
        }
    }
}
#define GAS __attribute__((address_space(1)))

constexpr size_t WS_WIN = WS_ACT_END;
constexpr size_t WS_WBR = WS_WIN + 88 * MiB;
constexpr size_t WS_WO  = WS_WBR + 16 * MiB;
constexpr size_t WS_WP  = WS_WO + 16 * MiB;
constexpr size_t WS_WG  = WS_WP + 2 * MiB;
constexpr size_t WS_WF1 = WS_WG + 16 * MiB;
constexpr size_t WS_WF2 = WS_WF1 + 44 * MiB;
constexpr size_t WS_WM1 = WS_WF2 + 22 * MiB;
constexpr size_t WS_WM2 = WS_WM1 + 448 * MiB;
constexpr size_t WS_RG1 = WS_WM2 + 224 * MiB;
constexpr size_t WS_WG8 = WS_RG1 + 16 * MiB;
constexpr size_t WS_XB8 = WS_WG8 + 16 * MiB;
constexpr size_t WS_END = WS_XB8 + 16 * MiB;

constexpr float W13_SC = 64.f, W2_SC = 128.f, X_SC = 16.f, H_SC = 8.f;
namespace pg8 {
constexpr int BM = 256, BK = 64, HALF = 128, HTB = HALF * BK * 2, STAGE_BYTES = 8 * HTB, NXCD = 8, WGM = 8;
__host__ __device__ constexpr __forceinline__ int lds_byte(int r, int c) { const int st = (r >> 4) * 2 + (c >> 5), rr = r & 15, cc = c & 31, ob = rr * 64 + cc * 2; return st * 1024 + (ob ^ (((ob >> 9) & 1) << 5)); }
__host__ __device__ __forceinline__ void stage_rc(int b, int& R, int& C) { const int st = b / 1024, sb = b % 1024, swz = sb ^ (((sb >> 9) & 1) << 5); R = (st >> 1) * 16 + swz / 64; C = (st & 1) * 32 + (swz % 64) / 2; }
__host__ __device__ __forceinline__ int perm32(int rho) { const int n = rho >> 4, i = rho & 15; return 8 * (i >> 2) + 4 * n + (i & 3); }

struct Unit { int pm, pn, aux; };
struct Gemm { const bf16* A; const bf16* Bt; int lda, ldb, K; };

DI bool tile_map(int i, int nM, int nN, int G, int c, int& pm, int& pn) {
    const int nwg = nM * nN; const long L = (long)i * G + c; if (L >= nwg) return false;
    int wgid = (int)L; { const int q = nwg / NXCD, r = nwg % NXCD, xcd = wgid % NXCD, off = wgid / NXCD; wgid = (xcd < r ? xcd * (q + 1) : r * (q + 1) + (xcd - r) * q) + off; }
    const int nig = WGM * nN, gid = wgid / nig, fm = gid * WGM, gsz = (nM - fm) < WGM ? (nM - fm) : WGM;
    pm = fm + ((wgid % nig) % gsz); pn = (wgid % nig) / gsz; return true;
}

typedef __bf16 bf16x2_t __attribute__((ext_vector_type(2)));
typedef float f32x2_t __attribute__((ext_vector_type(2)));
DI unsigned cvt_pk_bf16(float lo, float hi) { const f32x2_t v = {lo, hi}; return __builtin_bit_cast(unsigned, __builtin_convertvector(v, bf16x2_t)); }

typedef int v8i __attribute__((ext_vector_type(8)));
template <class Epi, class Sched, bool ALIGN_EPI, bool FP8 = false>
DI void gemm_phase(LAS unsigned char* lds, const Gemm g, const Sched& S, const Epi& E) {
    int tid = threadIdx.x; asm volatile("" : "+v"(tid));
    const int wid = __builtin_amdgcn_readfirstlane(tid >> 6), lane = tid & 63, wr = wid >> 2, wc = wid & 3, fr = lane & 15, fq = lane >> 4;
    const int K = g.K, nt = K / BK;
    unsigned voffA[2], voffB[2];
#pragma unroll
    for (int i = 0; i < 2; ++i) { int R, C; stage_rc(tid * 16 + i * 8192, R, C); const int Rb = Epi::PERM ? ((R & ~31) + perm32(R & 31)) : R;
        voffA[i] = (unsigned)(R * g.lda + C) * 2u; voffB[i] = (unsigned)(Rb * g.ldb + C) * 2u; }
    const size_t kstep = (size_t)(BK * 2);
    const size_t hstepA = (size_t)HALF * g.lda * 2, hstepB = (size_t)HALF * g.ldb * 2;
    const unsigned ldsw = (unsigned)wid * 1024u;
    const unsigned ldsbase = (unsigned)__builtin_amdgcn_readfirstlane((int)(unsigned)(size_t)lds) + ldsw;
    const int aoff = lds_byte(wr * 64 + fr, fq * 8), boff = lds_byte(wc * 32 + fr, fq * 8);
    const int aoff8a = lds_byte(wr * 64 + fr, fq * 16), boff8a = lds_byte(wc * 32 + fr, fq * 16);
    const LAS unsigned char* a8base = lds + aoff8a; const LAS unsigned char* b8base = lds + 4 * HTB + boff8a;
    if constexpr (FP8) { asm volatile("" : "+v"(a8base)); asm volatile("" : "+v"(b8base)); }
    static_assert(lds_byte(9, 24) == lds_byte(9, 16) + 16 && lds_byte(3, 56) == lds_byte(3, 48) + 16, "fp8 fragment pieces are adjacent");
#define PG8_SA(b, h) (((b) * 2 + (h)) * HTB)
#define PG8_SB(b, h) ((4 + (b) * 2 + (h)) * HTB)
#define PG8_STAGE(bufoff, gbase, voff) do { _Pragma("unroll") for (int _i = 0; _i < 2; ++_i) { unsigned keep_; \
        asm volatile("s_mov_b32 %0, m0\n\ts_mov_b32 m0, %3\n\ts_nop 0\n\tglobal_load_lds_dwordx4 %1, %2\n\ts_mov_b32 m0, %0" : "=&s"(keep_) : "v"((voff)[_i]), "s"((const char*)(gbase)), "s"(ldsbase + (unsigned)((bufoff) + _i * 8192)) : "memory"); } } while (0)
#define PG8_LDA(dst, b, h) do { if constexpr (FP8) { _Pragma("unroll") for (int m = 0; m < 4; ++m) { const u32x4 p0_ = *(const LAS u32x4*)(a8base + PG8_SA(b, h) + m * 2048), p1_ = *(const LAS u32x4*)(a8base + PG8_SA(b, h) + m * 2048 + 16); \
            dst##8[m] = (v8i){(int)p0_.x, (int)p0_.y, (int)p0_.z, (int)p0_.w, (int)p1_.x, (int)p1_.y, (int)p1_.z, (int)p1_.w}; } } \
        else { _Pragma("unroll") for (int m = 0; m < 4; ++m) _Pragma("unroll") for (int k = 0; k < 2; ++k) dst[m][k] = *(const LAS bf16x8*)(lds + PG8_SA(b, h) + aoff + m * 2048 + k * 1024); } } while (0)
#define PG8_LDB(dst, b, h) do { if constexpr (FP8) { _Pragma("unroll") for (int n = 0; n < 2; ++n) { const u32x4 p0_ = *(const LAS u32x4*)(b8base + (PG8_SB(b, h) - 4 * HTB) + n * 2048), p1_ = *(const LAS u32x4*)(b8base + (PG8_SB(b, h) - 4 * HTB) + n * 2048 + 16); \
            dst##8[n] = (v8i){(int)p0_.x, (int)p0_.y, (int)p0_.z, (int)p0_.w, (int)p1_.x, (int)p1_.y, (int)p1_.z, (int)p1_.w}; } } \
        else { _Pragma("unroll") for (int n = 0; n < 2; ++n) _Pragma("unroll") for (int k = 0; k < 2; ++k) dst[n][k] = *(const LAS bf16x8*)(lds + PG8_SB(b, h) + boff + n * 2048 + k * 1024); } } while (0)
#define PG8_MMA(ai, bj, At, Bt) do { __builtin_amdgcn_s_setprio(1); \
        if constexpr (FP8) { _Pragma("unroll") for (int m = 0; m < 4; ++m) _Pragma("unroll") for (int n = 0; n < 2; ++n) \
            acc[ai][bj][m][n] = __builtin_amdgcn_mfma_scale_f32_16x16x128_f8f6f4(Bt##8[n], At##8[m], acc[ai][bj][m][n], 0, 0, 0, ((bj) == 0 ? Epi::WSC0 : Epi::WSC1), 0, Epi::ASC); } \
        else { _Pragma("unroll") for (int m = 0; m < 4; ++m) _Pragma("unroll") for (int n = 0; n < 2; ++n) _Pragma("unroll") for (int k = 0; k < 2; ++k) \
            acc[ai][bj][m][n] = __builtin_amdgcn_mfma_f32_16x16x32_bf16(Bt[n][k], At[m][k], acc[ai][bj][m][n], 0, 0, 0); } \
        __builtin_amdgcn_s_setprio(0); } while (0)
#define PG8_WAIT_V(n) asm volatile("s_waitcnt vmcnt(" #n ")" ::: "memory")
#define PG8_WAIT_L(n) asm volatile("s_waitcnt lgkmcnt(" #n ")" ::: "memory")
#define PG8_BAR __builtin_amdgcn_s_barrier()
#define PG8_SCHED __builtin_amdgcn_sched_barrier(0)
    Unit cur, nxt; int ui = 0;
    if (!S.next(0, cur)) return;
    f32x4 acc[2][2][4][2];
#pragma unroll
    for (int a = 0; a < 2; ++a)
#pragma unroll
        for (int b = 0; b < 2; ++b)
#pragma unroll
            for (int m = 0; m < 4; ++m)
#pragma unroll
                for (int n = 0; n < 2; ++n) acc[a][b][m][n] = (f32x4){0.f, 0.f, 0.f, 0.f};
    bf16x8 At[4][2], B0[2][2], B1[2][2]; v8i At8[4], B08[2], B18[2];
    const char* cA = (const char*)g.A + S.a_off(cur); const char* cB = (const char*)g.Bt + S.b_off(cur);
    PG8_STAGE(PG8_SB(0, 0), cB, voffB); PG8_STAGE(PG8_SB(0, 1), cB + hstepB, voffB); PG8_STAGE(PG8_SA(0, 0), cA, voffA); PG8_STAGE(PG8_SA(0, 1), cA + hstepA, voffA);
    if (wr == 1) PG8_BAR;
    PG8_WAIT_V(2); PG8_BAR;
    PG8_STAGE(PG8_SB(1, 0), cB + kstep, voffB); PG8_STAGE(PG8_SA(1, 0), cA + kstep, voffA); PG8_STAGE(PG8_SB(1, 1), cB + hstepB + kstep, voffB);
    PG8_WAIT_V(6); PG8_BAR;
    for (;;) {
        const bool has_next = S.next(ui + 1, nxt);
        const char* nA = has_next ? (const char*)g.A + S.a_off(nxt) : cA; const char* nB = has_next ? (const char*)g.Bt + S.b_off(nxt) : cB;
        for (int t = 0; t < nt; t += 2) {
            if constexpr (Epi::MID) { if (t == (nt >> 1)) E.mid(acc, cur, wr, wc, fr, fq); }
            const bool last = (t == nt - 2);
            const char* a1 = cA + (size_t)(t + 1) * kstep;
            const char* a2 = last ? nA : cA + (size_t)(t + 2) * kstep; const char* b2 = last ? nB : cB + (size_t)(t + 2) * kstep;
            const char* a3 = a2 + kstep; const char* b3 = b2 + kstep;
            PG8_LDB(B0, 0, 0); PG8_LDB(B1, 0, 1); PG8_SCHED; PG8_LDA(At, 0, 0); PG8_STAGE(PG8_SA(1, 1), a1 + hstepA, voffA);
            PG8_WAIT_V(8); PG8_WAIT_L(0); PG8_BAR; PG8_MMA(0, 0, At, B0); PG8_MMA(0, 1, At, B1); PG8_BAR; PG8_SCHED;
            PG8_LDA(At, 0, 1); PG8_STAGE(PG8_SB(0, 0), b2, voffB); PG8_STAGE(PG8_SB(0, 1), b2 + hstepB, voffB); PG8_STAGE(PG8_SA(0, 0), a2, voffA);
            PG8_WAIT_V(8); PG8_WAIT_L(0); PG8_BAR; PG8_MMA(1, 0, At, B0); PG8_MMA(1, 1, At, B1); PG8_BAR; PG8_SCHED;
            PG8_LDB(B0, 1, 0); PG8_LDB(B1, 1, 1); PG8_SCHED; PG8_LDA(At, 1, 0); PG8_STAGE(PG8_SA(0, 1), a2 + hstepA, voffA);
            PG8_WAIT_V(8); PG8_WAIT_L(0); PG8_BAR; PG8_MMA(0, 0, At, B0); PG8_MMA(0, 1, At, B1); PG8_BAR; PG8_SCHED;
            PG8_LDA(At, 1, 1); PG8_STAGE(PG8_SB(1, 0), b3, voffB); PG8_STAGE(PG8_SB(1, 1), b3 + hstepB, voffB); PG8_STAGE(PG8_SA(1, 0), a3, voffA);
            PG8_WAIT_V(8); PG8_WAIT_L(0); PG8_BAR; PG8_MMA(1, 0, At, B0); PG8_MMA(1, 1, At, B1); PG8_BAR; PG8_SCHED;
        }
        if constexpr (ALIGN_EPI) { if (wr == 0) PG8_BAR; }
        E(acc, cur, wr, wc, fr, fq);
        if (!has_next) break;
#pragma unroll
        for (int a = 0; a < 2; ++a)
#pragma unroll
            for (int b = 0; b < 2; ++b)
#pragma unroll
                for (int m = 0; m < 4; ++m)
#pragma unroll
                    for (int n = 0; n < 2; ++n) acc[a][b][m][n] = (f32x4){0.f, 0.f, 0.f, 0.f};
        cur = nxt; cA = nA; cB = nB; ++ui;
        if constexpr (ALIGN_EPI) { if (wr == 1) PG8_BAR; }
    }
    PG8_WAIT_V(0);
    if constexpr (!ALIGN_EPI) { if (wr == 0) PG8_BAR; }
    PG8_BAR;
#undef PG8_SA
#undef PG8_SB
#undef PG8_STAGE
#undef PG8_LDA
#undef PG8_LDB
#undef PG8_MMA
#undef PG8_WAIT_V
#undef PG8_WAIT_L
#undef PG8_BAR
#undef PG8_SCHED
}

struct SchedPlain {
    int nM, nN, G, c; size_t astep, bstep;
    DI bool next(int i, Unit& u) const { u.aux = 0; return tile_map(i, nM, nN, G, c, u.pm, u.pn); }
    DI size_t a_off(const Unit& u) const { return (size_t)u.pm * astep; }
    DI size_t b_off(const Unit& u) const { return (size_t)u.pn * bstep; }
};
struct SchedA1 {
    int G, c;
    DI bool next(int i, Unit& u) const { int pn; u.aux = 0; if (!tile_map(i, NTOK / 256, 16, G, c, u.pm, pn)) return false; u.pn = pn < 8 ? pn : pn + 8; return true; }
    DI size_t a_off(const Unit& u) const { return (size_t)u.pm * (256 * D_ * 2); }
    DI size_t b_off(const Unit& u) const { return (size_t)u.pn * (256 * D_ * 2); }
};
struct SchedRG {
    int G, c;
    DI bool next(int i, Unit& u) const { int pn2; if (!tile_map(i, NTOK / 256, 8, G, c, u.pm, pn2)) return false; u.pn = pn2 >> 1; u.aux = pn2 & 1; return true; }
    DI size_t a_off(const Unit& u) const { return (size_t)u.pm * (256 * D_ * 2) + (size_t)u.aux * (D_ / 2 * 2); }
    DI size_t b_off(const Unit& u) const { return (size_t)(12 + u.pn) * (256 * D_ * 2) + (size_t)u.aux * (D_ / 2 * 2); }
};
struct SchedVT {
    int G, c;
    DI bool next(int i, Unit& u) const { u.aux = 0; return tile_map(i, 8, NTOK / 256, G, c, u.pm, u.pn); }
    DI size_t a_off(const Unit& u) const { const int phys = u.pm < 4 ? 8 + u.pm : 20 + u.pm; return (size_t)phys * (256 * D_ * 2); }
    DI size_t b_off(const Unit& u) const { return (size_t)u.pn * (256 * D_ * 2); }
};
struct SchedMerge {
    int G, c;
    DI bool next(int i, Unit& u) const { u.aux = i & 1; return tile_map(i >> 1, NTOK / 256, D_ / 256, G, c, u.pm, u.pn); }
    DI size_t a_off(const Unit& u) const { return (size_t)u.pm * (256 * D_ * 2) + (size_t)u.aux * (RW * 2); }
    DI size_t b_off(const Unit& u) const { return (size_t)u.aux * ((size_t)D_ * RW * 2) + (size_t)u.pn * (256 * RW * 2); }
};
struct SchedMoe {
    const LAS int* blk_e; int nM, nN, G, c; size_t astep, bstep, estep;
    DI bool next(int i, Unit& u) const { if (!tile_map(i, nM, nN, G, c, u.pm, u.pn)) return false; u.aux = __builtin_amdgcn_readfirstlane(blk_e[u.pm]); return true; }
    DI size_t a_off(const Unit& u) const { return (size_t)u.pm * astep; }
    DI size_t b_off(const Unit& u) const { return (size_t)u.aux * estep + (size_t)u.pn * bstep; }
};

struct SchedMoe2 {
    const LAS int* blk_e; int nM, G, c;
    DI bool next(int i, Unit& u) const { int pn2; if (!tile_map(i, nM, 2 * (D_ / 256), G, c, u.pm, pn2)) return false; u.pn = pn2 >> 1; u.aux = __builtin_amdgcn_readfirstlane(blk_e[u.pm]) | ((pn2 & 1) << 8); return true; }
    DI size_t a_off(const Unit& u) const { return (size_t)u.pm * ((size_t)256 * DFFE) + (size_t)(u.aux >> 8) * (DFFE / 2); }
    DI size_t b_off(const Unit& u) const { return (size_t)(u.aux & 255) * ((size_t)D_ * DFFE) + (size_t)u.pn * ((size_t)256 * DFFE) + (size_t)(u.aux >> 8) * (DFFE / 2); }
};
struct SchedTail {
    int nM, nN, G, c, r0; size_t astep, bstep;
    DI bool next(int i, Unit& u) const { u.aux = 0; const int nB = G - r0; if (c < r0) return false; return tile_map(i, nM, nN, nB, c - r0, u.pm, u.pn); }
    DI size_t a_off(const Unit& u) const { return (size_t)u.pm * astep; }
    DI size_t b_off(const Unit& u) const { return (size_t)u.pn * bstep; }
};

DI float sat8(float x) { return __builtin_amdgcn_fmed3f(x, -448.f, 448.f); }
DI unsigned pk4_fp8(float a, float b, float c, float d) { int w = __builtin_amdgcn_cvt_pk_fp8_f32(sat8(a), sat8(b), 0, false); w = __builtin_amdgcn_cvt_pk_fp8_f32(sat8(c), sat8(d), w, true); return (unsigned)w; }
DI float sig_(float x) { return __builtin_amdgcn_rcpf(1.0f + __builtin_amdgcn_exp2f(-1.4426950408889634f * x)); }
#define EPI_ROWS(u, wr, fr) const int row0 = (u).pm * BM + (wr) * 64 + (fr)
struct EpiA1 {
    static constexpr bool PERM = true, MID = false;
    bf16* H5; bf16* G; const float* bias; const float* cosT; const float* sinT;
    DI void operator()(const f32x4 (&acc)[2][2][4][2], const Unit& u, int wr, int wc, int fr, int fq) const {
        EPI_ROWS(u, wr, fr); const int t = u.pn;
        if (t < 8) {
            const float sc = (t < 4) ? QK_SCALE : 1.0f;
            bf16* base = H5 + (size_t)(t >> 2) * NTOK * 1024 + (t & 3) * 256 + wc * 16 + 4 * fq;
#pragma unroll
            for (int ai = 0; ai < 2; ++ai)
#pragma unroll
                for (int m = 0; m < 4; ++m) { const int row = row0 + ai * HALF + m * 16; const int pos = row & (S_ - 1);
                    const f32x4 c = *(const f32x4*)(cosT + pos * 64 + wc * 16 + 4 * fq) * sc, s = *(const f32x4*)(sinT + pos * 64 + wc * 16 + 4 * fq) * sc;
                    bf16* rowp = base + (size_t)row * 1024;
#pragma unroll
                    for (int bj = 0; bj < 2; ++bj) { const f32x4 x1 = acc[ai][bj][m][0], x2 = acc[ai][bj][m][1];
                        const f32x4 o1 = x1 * c - x2 * s, o2 = x1 * s + x2 * c;
                        *(u32x2*)(rowp + bj * HALF) = (u32x2){cvt_pk_bf16(o1[0], o1[1]), cvt_pk_bf16(o1[2], o1[3])};
                        *(u32x2*)(rowp + bj * HALF + 64) = (u32x2){cvt_pk_bf16(o2[0], o2[1]), cvt_pk_bf16(o2[2], o2[3])}; } }
        } else if (t < 28) {
            const int slot = t < 8 ? (t >> 2) : (t >> 2) - 1;
            bf16* base = H5 + (size_t)slot * NTOK * 1024 + (t & 3) * 256 + wc * 32 + 8 * fq;
#pragma unroll
            for (int ai = 0; ai < 2; ++ai)
#pragma unroll
                for (int m = 0; m < 4; ++m) { bf16* rowp = base + (size_t)(row0 + ai * HALF + m * 16) * 1024;
#pragma unroll
                    for (int bj = 0; bj < 2; ++bj) { const f32x4 v0 = acc[ai][bj][m][0], v1 = acc[ai][bj][m][1];
                        u32x4 w; w.x = cvt_pk_bf16(v0[0], v0[1]); w.y = cvt_pk_bf16(v0[2], v0[3]); w.z = cvt_pk_bf16(v1[0], v1[1]); w.w = cvt_pk_bf16(v1[2], v1[3]);
                        *(u32x4*)(rowp + bj * HALF) = w; } }
        } else {
            const int col0 = (t - 28) * 256 + wc * 32 + 8 * fq;
            f32x4 bv[2][2];
#pragma unroll
            for (int bj = 0; bj < 2; ++bj)
#pragma unroll
                for (int n = 0; n < 2; ++n) bv[bj][n] = *(const f32x4*)(bias + col0 + bj * HALF + 4 * n);
#pragma unroll
            for (int ai = 0; ai < 2; ++ai)
#pragma unroll
                for (int m = 0; m < 4; ++m) { bf16* rowp = G + (size_t)(row0 + ai * HALF + m * 16) * 4096 + col0;
#pragma unroll
                    for (int bj = 0; bj < 2; ++bj) { const f32x4 v0 = acc[ai][bj][m][0] + bv[bj][0], v1 = acc[ai][bj][m][1] + bv[bj][1];
                        u32x4 w; w.x = cvt_pk_bf16(sig_(v0[0]), sig_(v0[1])); w.y = cvt_pk_bf16(sig_(v0[2]), sig_(v0[3])); w.z = cvt_pk_bf16(sig_(v1[0]), sig_(v1[1])); w.w = cvt_pk_bf16(sig_(v1[2]), sig_(v1[3]));
                        *(u32x4*)(rowp + bj * HALF) = w; } }
        }
    }
};
struct EpiBf16 {
    static constexpr bool PERM = true, MID = false;
    bf16* O; int ldc;
    DI void operator()(const f32x4 (&acc)[2][2][4][2], const Unit& u, int wr, int wc, int fr, int fq) const {
        EPI_ROWS(u, wr, fr); bf16* base = O + u.pn * BM + wc * 32 + 8 * fq;
#pragma unroll
        for (int ai = 0; ai < 2; ++ai)
#pragma unroll
            for (int m = 0; m < 4; ++m) { bf16* rowp = base + (size_t)(row0 + ai * HALF + m * 16) * ldc;
#pragma unroll
                for (int bj = 0; bj < 2; ++bj) { const f32x4 v0 = acc[ai][bj][m][0], v1 = acc[ai][bj][m][1];
                    u32x4 w; w.x = cvt_pk_bf16(v0[0], v0[1]); w.y = cvt_pk_bf16(v0[2], v0[3]); w.z = cvt_pk_bf16(v1[0], v1[1]); w.w = cvt_pk_bf16(v1[2], v1[3]);
                    *(u32x4*)(rowp + bj * HALF) = w; } }
    }
};
struct EpiRG {
    static constexpr bool PERM = true, MID = false;
    bf16* R0; bf16* R1;
    DI void operator()(const f32x4 (&acc)[2][2][4][2], const Unit& u, int wr, int wc, int fr, int fq) const {
        EPI_ROWS(u, wr, fr); bf16* base = (u.aux ? R1 : R0) + u.pn * BM + wc * 32 + 8 * fq;
#pragma unroll
        for (int ai = 0; ai < 2; ++ai)
#pragma unroll
            for (int m = 0; m < 4; ++m) { bf16* rowp = base + (size_t)(row0 + ai * HALF + m * 16) * 1024;
#pragma unroll
                for (int bj = 0; bj < 2; ++bj) { const f32x4 v0 = acc[ai][bj][m][0], v1 = acc[ai][bj][m][1];
                    u32x4 w; w.x = cvt_pk_bf16(v0[0], v0[1]); w.y = cvt_pk_bf16(v0[2], v0[3]); w.z = cvt_pk_bf16(v1[0], v1[1]); w.w = cvt_pk_bf16(v1[2], v1[3]);
                    *(u32x4*)(rowp + bj * HALF) = w; } }
    }
};
struct EpiSwi8 {
    static constexpr bool PERM = true, MID = false;
    static constexpr int ASC = 122 * 0x01010101, WSC0 = ASC, WSC1 = 125 * 0x01010101;
    static_assert(W13_SC * X_SC == 1024.f && H_SC == 8.f, "block scales above");
    unsigned char* Hm; int ld;
    DI void operator()(const f32x4 (&acc)[2][2][4][2], const Unit& u, int wr, int wc, int fr, int fq) const {
        int row0 = u.pm * BM + wr * 64 + fr; asm volatile("" : "+v"(row0));
        int coff = wc * 32 + 8 * fq; asm volatile("" : "+v"(coff));
        unsigned char* base = Hm + u.pn * HALF + coff;
#pragma unroll
        for (int ai = 0; ai < 2; ++ai)
#pragma unroll
            for (int m = 0; m < 4; ++m) { unsigned char* rowp = base + (size_t)(row0 + ai * HALF + m * 16) * ld;
                float o[8];
#pragma unroll
                for (int n = 0; n < 2; ++n)
#pragma unroll
                    for (int e = 0; e < 4; ++e) { const float a = acc[ai][0][m][n][e], b = acc[ai][1][m][n][e]; o[n * 4 + e] = a * sig_(a) * b; }
                *(u32x2*)rowp = (u32x2){pk4_fp8(o[0], o[1], o[2], o[3]), pk4_fp8(o[4], o[5], o[6], o[7])}; }
    }
};
struct EpiGate8 {
    static constexpr bool PERM = true, MID = false;
    static constexpr int ASC = 122 * 0x01010101, WSC0 = ASC, WSC1 = ASC;
    bf16* G; const float* bias;
    DI void operator()(const f32x4 (&acc)[2][2][4][2], const Unit& u, int wr, int wc, int fr, int fq) const {
        int row0 = u.pm * BM + wr * 64 + fr; asm volatile("" : "+v"(row0));
        const int col0 = u.pn * BM + wc * 32 + 8 * fq;
        f32x4 bv[2][2];
#pragma unroll
        for (int bj = 0; bj < 2; ++bj)
#pragma unroll
            for (int n = 0; n < 2; ++n) bv[bj][n] = *(const f32x4*)(bias + col0 + bj * HALF + 4 * n);
#pragma unroll
        for (int ai = 0; ai < 2; ++ai)
#pragma unroll
            for (int m = 0; m < 4; ++m) { bf16* rowp = G + (size_t)(row0 + ai * HALF + m * 16) * 4096 + col0;
#pragma unroll
                for (int bj = 0; bj < 2; ++bj) { const f32x4 v0 = acc[ai][bj][m][0] + bv[bj][0], v1 = acc[ai][bj][m][1] + bv[bj][1];
                    u32x4 w; w.x = cvt_pk_bf16(sig_(v0[0]), sig_(v0[1])); w.y = cvt_pk_bf16(sig_(v0[2]), sig_(v0[3])); w.z = cvt_pk_bf16(sig_(v1[0]), sig_(v1[1])); w.w = cvt_pk_bf16(sig_(v1[2]), sig_(v1[3]));
                    *(u32x4*)(rowp + bj * HALF) = w; } }
    }
};
struct EpiYE2 {
    static constexpr bool PERM = true, MID = false;
    static constexpr int ASC = 122 * 0x01010101, WSC0 = ASC, WSC1 = ASC;
    static_assert(W2_SC * H_SC == 1024.f, "block scale above");
    bf16* O;
    DI void operator()(const f32x4 (&acc)[2][2][4][2], const Unit& u, int wr, int wc, int fr, int fq) const {
        int row0 = u.pm * BM + wr * 64 + fr; asm volatile("" : "+v"(row0));
        int coff = wc * 32 + 8 * fq; asm volatile("" : "+v"(coff));
        bf16* base = O + (size_t)(u.aux >> 8) * ((size_t)MOE_P * D_) + u.pn * BM + coff;
#pragma unroll
        for (int ai = 0; ai < 2; ++ai)
#pragma unroll
            for (int m = 0; m < 4; ++m) { bf16* rowp = base + (size_t)(row0 + ai * HALF + m * 16) * D_;
#pragma unroll
                for (int bj = 0; bj < 2; ++bj) { const f32x4 v0 = acc[ai][bj][m][0], v1 = acc[ai][bj][m][1];
                    u32x4 w; w.x = cvt_pk_bf16(v0[0], v0[1]); w.y = cvt_pk_bf16(v0[2], v0[3]); w.z = cvt_pk_bf16(v1[0], v1[1]); w.w = cvt_pk_bf16(v1[2], v1[3]);
                    *(u32x4*)(rowp + bj * HALF) = w; } }
    }
};
struct EpiSwi {
    static constexpr bool PERM = true, MID = false;
    bf16* Hm; int ld;
    DI void operator()(const f32x4 (&acc)[2][2][4][2], const Unit& u, int wr, int wc, int fr, int fq) const {
        EPI_ROWS(u, wr, fr); bf16* base = Hm + u.pn * HALF + wc * 32 + 8 * fq;
#pragma unroll
        for (int ai = 0; ai < 2; ++ai)
#pragma unroll
            for (int m = 0; m < 4; ++m) { bf16* rowp = base + (size_t)(row0 + ai * HALF + m * 16) * ld;
                float o[8];
#pragma unroll
                for (int n = 0; n < 2; ++n)
#pragma unroll
                    for (int e = 0; e < 4; ++e) { const float a = acc[ai][0][m][n][e], b = acc[ai][1][m][n][e]; o[n * 4 + e] = a * sig_(a) * b; }
                u32x4 w; w.x = cvt_pk_bf16(o[0], o[1]); w.y = cvt_pk_bf16(o[2], o[3]); w.z = cvt_pk_bf16(o[4], o[5]); w.w = cvt_pk_bf16(o[6], o[7]);
                *(u32x4*)rowp = w; }
    }
};
DI void unpack8f(const u32x4 w, f32x4& lo, f32x4& hi) {
    lo[0] = __builtin_bit_cast(float, w.x << 16); lo[1] = __builtin_bit_cast(float, w.x & 0xffff0000u); lo[2] = __builtin_bit_cast(float, w.y << 16); lo[3] = __builtin_bit_cast(float, w.y & 0xffff0000u);
    hi[0] = __builtin_bit_cast(float, w.z << 16); hi[1] = __builtin_bit_cast(float, w.z & 0xffff0000u); hi[2] = __builtin_bit_cast(float, w.w << 16); hi[3] = __builtin_bit_cast(float, w.w & 0xffff0000u);
}
struct EpiMerge {
    static constexpr bool PERM = true, MID = true;
    static constexpr int MIDB = 2;
    const bf16* G; bf16* Mg;
    DI void mid(f32x4 (&acc)[2][2][4][2], const Unit& u, int wr, int wc, int fr, int fq) const {
        int row0 = u.pm * BM + wr * 64 + fr; asm volatile("" : "+v"(row0));
        const int col0 = u.pn * BM + wc * 32 + 8 * fq;
#pragma unroll
        for (int ai = 0; ai < 2; ++ai)
#pragma unroll
            for (int mp = 0; mp < MIDB; ++mp) {
                u32x4 gr[4 / MIDB][2], gs[4 / MIDB][2];
#pragma unroll
                for (int mm = 0; mm < 4 / MIDB; ++mm) { const bf16* gp = G + (size_t)(row0 + ai * HALF + (mp * (4 / MIDB) + mm) * 16) * 4096 + col0;
#pragma unroll
                    for (int bj = 0; bj < 2; ++bj) { gr[mm][bj] = *(const u32x4*)(gp + bj * HALF); gs[mm][bj] = *(const u32x4*)(gp + 2048 + bj * HALF); } }
#pragma unroll
                for (int mm = 0; mm < 4 / MIDB; ++mm) { const int m = mp * (4 / MIDB) + mm;
#pragma unroll
                    for (int bj = 0; bj < 2; ++bj) { f32x4 r0, r1, s0, s1; unpack8f(gr[mm][bj], r0, r1); unpack8f(gs[mm][bj], s0, s1);
#pragma unroll
                        for (int e = 0; e < 4; ++e) { acc[ai][bj][m][0][e] *= r0[e] * __builtin_amdgcn_rcpf(__builtin_fmaxf(s0[e], 1e-30f)); acc[ai][bj][m][1][e] *= r1[e] * __builtin_amdgcn_rcpf(__builtin_fmaxf(s1[e], 1e-30f)); }
                        asm volatile("" : "+v"(acc[ai][bj][m][0]), "+v"(acc[ai][bj][m][1])); } }
                asm volatile("" ::: "memory"); }
    }
    DI void operator()(const f32x4 (&acc)[2][2][4][2], const Unit& u, int wr, int wc, int fr, int fq) const {
        int row0 = u.pm * BM + wr * 64 + fr; asm volatile("" : "+v"(row0));
        const int col0 = u.pn * BM + wc * 32 + 8 * fq;
#pragma unroll
        for (int ai = 0; ai < 2; ++ai)
#pragma unroll
            for (int m = 0; m < 4; ++m) { const size_t r = (size_t)(row0 + ai * HALF + m * 16);
#pragma unroll
                for (int bj = 0; bj < 2; ++bj) { const int c = col0 + bj * HALF; f32x4 s0, s1; unpack8f(*(const u32x4*)(G + r * 4096 + 2048 + c), s0, s1);
                    const f32x4 v0 = acc[ai][bj][m][0] * s0, v1 = acc[ai][bj][m][1] * s1;
                    u32x4 w; w.x = cvt_pk_bf16(v0[0], v0[1]); w.y = cvt_pk_bf16(v0[2], v0[3]); w.z = cvt_pk_bf16(v1[0], v1[1]); w.w = cvt_pk_bf16(v1[2], v1[3]);
                    *(u32x4*)(Mg + r * D_ + c) = w; }
                asm volatile("" ::: "memory"); }
    }
};
struct EpiPleB {
    static constexpr bool PERM = true, MID = false;
    const bf16* PWB; bf16* PLEB;
    DI void operator()(const f32x4 (&acc)[2][2][4][2], const Unit& u, int wr, int wc, int fr, int fq) const {
        int row0 = u.pm * BM + wr * 64 + fr; asm volatile("" : "+v"(row0));
        const int col0 = u.pn * BM + wc * 32 + 8 * fq;
#pragma unroll
        for (int ai = 0; ai < 2; ++ai)
#pragma unroll
            for (int m = 0; m < 4; ++m) { const size_t r = (size_t)(row0 + ai * HALF + m * 16);
#pragma unroll
                for (int bj = 0; bj < 2; ++bj) { const size_t o = r * D_ + col0 + bj * HALF; f32x4 p0, p1; unpack8f(*(const u32x4*)(PWB + o), p0, p1);
                    const f32x4 a0 = acc[ai][bj][m][0], a1 = acc[ai][bj][m][1];
                    u32x4 w; w.x = cvt_pk_bf16(sig_(a0[0]) * p0[0], sig_(a0[1]) * p0[1]); w.y = cvt_pk_bf16(sig_(a0[2]) * p0[2], sig_(a0[3]) * p0[3]);
                    w.z = cvt_pk_bf16(sig_(a1[0]) * p1[0], sig_(a1[1]) * p1[1]); w.w = cvt_pk_bf16(sig_(a1[2]) * p1[2], sig_(a1[3]) * p1[3]);
                    *(u32x4*)(PLEB + o) = w; }
                if (m & 1) asm volatile("" ::: "memory"); }
    }
};
template <bool HAS_R1> struct EpiYb {
    static constexpr bool PERM = true, MID = false;
    const bf16* R0; const bf16* R1; bf16* Yo;
    DI void operator()(const f32x4 (&acc)[2][2][4][2], const Unit& u, int wr, int wc, int fr, int fq) const {
        int row0 = u.pm * BM + wr * 64 + fr; asm volatile("" : "+v"(row0));
        const int col0 = u.pn * BM + wc * 32 + 8 * fq;
#pragma unroll
        for (int ai = 0; ai < 2; ++ai)
#pragma unroll
            for (int m = 0; m < 4; ++m) { const size_t r = (size_t)(row0 + ai * HALF + m * 16);
#pragma unroll
                for (int bj = 0; bj < 2; ++bj) { const size_t o = r * D_ + col0 + bj * HALF; f32x4 x0, x1; unpack8f(*(const u32x4*)(R0 + o), x0, x1);
                    f32x4 v0 = ALPHA * x0 + acc[ai][bj][m][0], v1 = ALPHA * x1 + acc[ai][bj][m][1];
                    if (HAS_R1) { f32x4 q0, q1; unpack8f(*(const u32x4*)(R1 + o), q0, q1); v0 = v0 + q0; v1 = v1 + q1; }
                    u32x4 w; w.x = cvt_pk_bf16(v0[0], v0[1]); w.y = cvt_pk_bf16(v0[2], v0[3]); w.z = cvt_pk_bf16(v1[0], v1[1]); w.w = cvt_pk_bf16(v1[2], v1[3]);
                    *(u32x4*)(Yo + o) = w; }
                if (m & 1) asm volatile("" ::: "memory"); }
    }
};
template <int MODE> struct EpiF32 {
    static constexpr bool PERM = false, MID = false;
    float* C; const float* R0; const float* R1;
    DI void operator()(const f32x4 (&acc)[2][2][4][2], const Unit& u, int wr, int wc, int fr, int fq) const {
        EPI_ROWS(u, wr, fr); const int col0 = u.pn * BM + wc * 32 + 4 * fq;
#pragma unroll
        for (int ai = 0; ai < 2; ++ai)
#pragma unroll
            for (int m = 0; m < 4; ++m) { const size_t off = (size_t)(row0 + ai * HALF + m * 16) * D_ + col0;
#pragma unroll
                for (int bj = 0; bj < 2; ++bj)
#pragma unroll
                    for (int n = 0; n < 2; ++n) { const size_t o = off + bj * HALF + n * 16; f32x4 v = acc[ai][bj][m][n];
                        if (MODE == 1) v = ALPHA * *(const f32x4*)(R0 + o) + v;
                        if (MODE == 2) { const f32x4 p = *(const f32x4*)(R0 + o); v[0] = sig_(v[0]) * p[0]; v[1] = sig_(v[1]) * p[1]; v[2] = sig_(v[2]) * p[2]; v[3] = sig_(v[3]) * p[3]; }
                        if (MODE == 3) v = (ALPHA * *(const f32x4*)(R0 + o) + v) + *(const f32x4*)(R1 + o);
                        *(f32x4*)(C + o) = v; }
                if (m & 1) asm volatile("" ::: "memory"); }
    }
};
}

#define XB_TMO      128
#define XB_XCNT(j)  (256  + 64 * (j))
#define XB_XSUB(j)  (1280 + 64 * (j))
#define XB_XGEN(j)  (2304 + 64 * (j))
#define XB_TOP      3328
#define XB_TOPGEN   3392
#define XCD_BAR_WORDS 3456
#define XB_SPIN_CAP (1u << 18)
__device__ __forceinline__ unsigned xb_ld(unsigned* p)              { return __hip_atomic_load(p, __ATOMIC_RELAXED, __HIP_MEMORY_SCOPE_AGENT); }
__device__ __forceinline__ unsigned xb_add(unsigned* p, unsigned v) { return __hip_atomic_fetch_add(p, v, __ATOMIC_RELAXED, __HIP_MEMORY_SCOPE_AGENT); }
__device__ __forceinline__ unsigned xb_xcc_id() { return (unsigned)__builtin_amdgcn_s_getreg((3 << 11) | 20) & 0xFu; }
#define XB_SPIN(cond, bar) do { unsigned _sp = 0; while (cond) { __builtin_amdgcn_s_sleep(1); \
    if ((++_sp & 255u) == 0u) { if (xb_ld(&(bar)[XB_TMO])) break; if (_sp > XB_SPIN_CAP) { atomicAdd(&(bar)[XB_TMO], 1u); break; } } } } while (0)
struct XcdBarrier { unsigned* bar; unsigned x; volatile LAS unsigned* st; };
__device__ __forceinline__ XcdBarrier xcd_barrier_post(unsigned* bar, volatile LAS unsigned* st) {
    XcdBarrier b; b.bar = bar; b.x = xb_xcc_id(); b.st = st;
    if (threadIdx.x == 0) (void)xb_add(&bar[XB_XCNT(b.x)], 1u);
    return b;
}
__device__ __forceinline__ void xcd_barrier_complete(unsigned* bar, unsigned x, unsigned& nloc, unsigned& nx) {
    const unsigned G = gridDim.x * gridDim.y * gridDim.z;
    unsigned sum, cnt, mine, sp = 0u;
    for (;;) {
        sum = 0u; cnt = 0u; mine = 0u;
#pragma unroll
        for (unsigned j = 0; j < 16; ++j) { const unsigned c = xb_ld(&bar[XB_XCNT(j)]); sum += c; cnt += (c > 0u) ? 1u : 0u; mine = (j == x) ? c : mine; }
        if (sum == G) break;
        __builtin_amdgcn_s_sleep(1);
        if ((++sp & 255u) == 0u) { if (xb_ld(&bar[XB_TMO])) break; if (sp > XB_SPIN_CAP) { atomicAdd(&bar[XB_TMO], 1u); break; } }
    }
    nloc = mine > 0u ? mine : 1u; nx = cnt > 0u ? cnt : 1u;
}
__device__ __forceinline__ void xcd_barrier(const XcdBarrier& b) {
    asm volatile("s_waitcnt vmcnt(0)" ::: "memory");
    __syncthreads();
    if (threadIdx.x == 0) {
        unsigned* bar = b.bar;
        __builtin_amdgcn_s_waitcnt(0);
        unsigned nloc = b.st[0], nx = b.st[1];
        if (nloc == 0u) { xcd_barrier_complete(bar, b.x, nloc, nx); b.st[0] = nloc; b.st[1] = nx; }
        const unsigned old = xb_add(&bar[XB_XSUB(b.x)], 1u);
        const unsigned gen = old / nloc;
        if (old + 1u == (gen + 1u) * nloc) {
            __builtin_amdgcn_fence(__ATOMIC_RELEASE, "agent");
            asm volatile("s_waitcnt vmcnt(0)" ::: "memory");
            const unsigned og = xb_add(&bar[XB_TOP], 1u);
            const unsigned tg = og / nx;
            if (og + 1u == (tg + 1u) * nx) xb_add(&bar[XB_TOPGEN], 1u);
            else XB_SPIN(xb_ld(&bar[XB_TOPGEN]) == tg, bar);
            __builtin_amdgcn_fence(__ATOMIC_ACQUIRE, "agent");
            xb_add(&bar[XB_XGEN(b.x)], 1u);
            asm volatile("s_waitcnt vmcnt(0)" ::: "memory");
        } else {
            XB_SPIN(xb_ld(&bar[XB_XGEN(b.x)]) == gen, bar);
            __builtin_amdgcn_fence(__ATOMIC_ACQUIRE, "agent");
            asm volatile("s_waitcnt vmcnt(0)" ::: "memory");
        }
    }
    __syncthreads();
}

constexpr int RING_BYTES = 131072;
constexpr int LDSCTL_OFF = RING_BYTES, MISC_OFF = LDSCTL_OFF + 320;
constexpr int LDS_BYTES = 147456;
constexpr int CW_BAR = 4096;

#define LDS_WAIT() asm volatile("s_waitcnt lgkmcnt(0)" ::: "memory")

struct CvtSeg { const float* W; bf16* dst; int E, K, N, ncols, mode, dld, kofs; };
DI int rot_slot(int d) { return 32 * ((d & 63) >> 4) + 8 * ((d >> 2) & 3) + 4 * (d >> 6) + (d & 3); }
DI void cvt_decode(const CvtSeg& s, int it, const float*& src, bf16*& d, int& k0, int& nloc0) {
    const int nnb = s.ncols / 64, per = (s.K / 64) * nnb; const int e = it / per, r = it - e * per, kb = r / nnb, nb = r - kb * nnb, n0 = nb * 64; k0 = kb * 64; nloc0 = n0 & 127;
    src = s.W + (size_t)e * s.K * s.N + (size_t)k0 * s.N + n0;
    if (s.mode == 0) d = s.dst + (size_t)e * s.ncols * s.dld + (size_t)n0 * s.dld + s.kofs + k0;
    else if (s.mode == 3) d = s.dst + (size_t)(n0 & ~127) * s.dld + s.kofs + k0;
    else d = s.dst + (size_t)e * 2 * s.ncols * s.dld + (size_t)((n0 >> 7) * 256 + (n0 & 127) + (s.mode == 2 ? 128 : 0)) * s.dld + s.kofs + k0;
}
DI void cvt_load(const CvtSeg& s, int it, f32x4 (&v)[16], int lane) {
    const float* src; bf16* d; int k0, nl0; cvt_decode(s, it, src, d, k0, nl0);
    const int half = lane >> 4, n4 = (lane & 15) * 4; src += (size_t)(2 * half) * s.N + n4;
#pragma unroll
    for (int j = 0; j < 8; ++j) { v[2 * j] = __builtin_nontemporal_load((const f32x4*)(src + (size_t)(8 * j) * s.N)); v[2 * j + 1] = __builtin_nontemporal_load((const f32x4*)(src + (size_t)(8 * j + 1) * s.N)); }
}
DI void cvt_store(const CvtSeg& s, int it, const f32x4 (&v)[16], LAS unsigned* T, int lane) {
    const float* src; bf16* d; int k0, nl0; cvt_decode(s, it, src, d, k0, nl0);
    const int half = lane >> 4, n4 = (lane & 15) * 4;
#pragma unroll
    for (int j = 0; j < 8; ++j)
#pragma unroll
        for (int q = 0; q < 4; ++q) T[(n4 + q) * 33 + 4 * j + half] = pg8::cvt_pk_bf16(v[2 * j][q], v[2 * j + 1][q]);
    LDS_WAIT();
    const int c = lane & 7;
#pragma unroll
    for (int jj = 0; jj < 8; ++jj) { const int n = (lane >> 3) + 8 * jj; const LAS unsigned* t = T + n * 33 + 4 * c;
        u32x4 o; o.x = t[0]; o.y = t[1]; o.z = t[2]; o.w = t[3];
        const int row = (s.mode == 3) ? rot_slot(nl0 + n) : n;
        *(u32x4*)(d + (size_t)row * s.dld + 8 * c) = o; }
    LDS_WAIT();
}
using pg8::pk4_fp8;
DI void cvt8_decode(const CvtSeg& s, int it, const float*& src, unsigned char*& d) {
    const int nnb = s.ncols / 64, per = (s.K / 128) * nnb; const int e = it / per, r = it - e * per, kb = r / nnb, nb = r - kb * nnb, n0 = nb * 64, k0 = kb * 128;
    src = s.W + (size_t)e * s.K * s.N + (size_t)k0 * s.N + n0;
    if (s.mode == 0) d = (unsigned char*)s.dst + (size_t)e * s.ncols * s.dld + (size_t)n0 * s.dld + s.kofs + k0;
    else d = (unsigned char*)s.dst + (size_t)e * 2 * s.ncols * s.dld + (size_t)((n0 >> 7) * 256 + (n0 & 127) + (s.mode == 2 ? 128 : 0)) * s.dld + s.kofs + k0;
}
DI void cvt8_load_half(const CvtSeg& s, int it, int hh, f32x4 (&v)[16], int lane) {
    const float* src; unsigned char* d; cvt8_decode(s, it, src, d);
    src += (size_t)(64 * hh + 4 * (lane >> 4)) * s.N + (lane & 15) * 4;
#pragma unroll
    for (int j = 0; j < 4; ++j)
#pragma unroll
        for (int i = 0; i < 4; ++i) v[4 * j + i] = __builtin_nontemporal_load((const f32x4*)(src + (size_t)(16 * j + i) * s.N));
}
DI void cvt8_pack_half(const f32x4 (&v)[16], int hh, float sc, LAS unsigned* T, int lane) {
    const int kq = lane >> 4, n4 = (lane & 15) * 4;
#pragma unroll
    for (int j = 0; j < 4; ++j)
#pragma unroll
        for (int q = 0; q < 4; ++q) T[(n4 + q) * 33 + 4 * (4 * hh + j) + kq] = pk4_fp8(v[4 * j][q] * sc, v[4 * j + 1][q] * sc, v[4 * j + 2][q] * sc, v[4 * j + 3][q] * sc);
}
DI void cvt8_store(const CvtSeg& s, int it, LAS unsigned* T, int lane) {
    const float* src; unsigned char* d; cvt8_decode(s, it, src, d);
    LDS_WAIT();
    const int c = lane & 7;
#pragma unroll
    for (int jj = 0; jj < 8; ++jj) { const int n = (lane >> 3) + 8 * jj; const LAS unsigned* t = T + n * 33 + 4 * c;
        u32x4 o; o.x = t[0]; o.y = t[1]; o.z = t[2]; o.w = t[3];
        *(u32x4*)(d + (size_t)n * s.dld + 16 * c) = o; }
    LDS_WAIT();
}
DI void cvt_seg8(const CvtSeg& s, float sc, int& rot, int gw, int NGW, LAS unsigned* T, int lane) {
    const int total = s.E * (s.K / 128) * (s.ncols / 64);
    int it = gw - rot; if (it < 0) it += NGW;
    rot = (rot + total) % NGW;
    f32x4 va[16], vb[16];
    if (it < total) cvt8_load_half(s, it, 0, va, lane);
    while (it < total) {
        cvt8_load_half(s, it, 1, vb, lane);
        cvt8_pack_half(va, 0, sc, T, lane);
        const int itn = it + NGW;
        if (itn < total) cvt8_load_half(s, itn, 0, va, lane);
        cvt8_pack_half(vb, 1, sc, T, lane);
        cvt8_store(s, it, T, lane);
        it = itn;
    }
}
DI void cvt_seg(const CvtSeg& s, int& rot, int gw, int NGW, LAS unsigned* T, int lane) {
    const int total = s.E * (s.K / 64) * (s.ncols / 64);
    int it = gw - rot; if (it < 0) it += NGW;
    rot = (rot + total) % NGW;
    f32x4 va[16], vb[16];
    if (it < total) cvt_load(s, it, va, lane);
    while (it < total) {
        int itn = it + NGW;
        if (itn < total) cvt_load(s, itn, vb, lane);
        cvt_store(s, it, va, T, lane);
        it = itn; if (it >= total) break;
        itn = it + NGW;
        if (itn < total) cvt_load(s, itn, va, lane);
        cvt_store(s, it, vb, T, lane);
        it = itn;
    }
}

namespace att {
constexpr int KS_ = 272, VS_ = 136, KBUF = 64 * KS_, VBUF = 128 * VS_;
constexpr int RTS = 272, RT_OFF = 73728;
constexpr float C2 = QK_SCALE * 1.4426950408889634f;
typedef short s16x4 __attribute__((ext_vector_type(4)));
DI void unpack8(const u32x4 w, float (&f)[8]) {
    f[0] = __builtin_bit_cast(float, w.x << 16); f[1] = __builtin_bit_cast(float, w.x & 0xffff0000u); f[2] = __builtin_bit_cast(float, w.y << 16); f[3] = __builtin_bit_cast(float, w.y & 0xffff0000u);
    f[4] = __builtin_bit_cast(float, w.z << 16); f[5] = __builtin_bit_cast(float, w.z & 0xffff0000u); f[6] = __builtin_bit_cast(float, w.w << 16); f[7] = __builtin_bit_cast(float, w.w & 0xffff0000u);
}
DI u32x4 pack8(const float (&f)[8]) { u32x4 w; w.x = pg8::cvt_pk_bf16(f[0], f[1]); w.y = pg8::cvt_pk_bf16(f[2], f[3]); w.z = pg8::cvt_pk_bf16(f[4], f[5]); w.w = pg8::cvt_pk_bf16(f[6], f[7]); return w; }
DI u32x4 scale8(const u32x4 w, float s) { float x[8]; unpack8(w, x);
#pragma unroll
    for (int j = 0; j < 8; ++j) x[j] *= s;
    return pack8(x); }

struct Tile { u32x4 ka, kb, va, vb; };

template <int BR>
DI void unit(LAS unsigned char* lds, const bf16* __restrict__ Q, const bf16* __restrict__ Kx, const bf16* __restrict__ VT, const bf16* __restrict__ RG, const bf16* __restrict__ RG1, bf16* __restrict__ O, int b, int h, int qb) {
    int tid = threadIdx.x; asm volatile("" : "+v"(tid));
    const int lane = tid & 63, wave = __builtin_amdgcn_readfirstlane(tid >> 6);
    const int r32 = lane & 31, hf = lane >> 5;
    const int t0 = qb * 256, tw0 = t0 + 32 * wave, t = tw0 + r32;
    const size_t tok = (size_t)b * S_ + t;
    bf16x8 qf[8];
    { const bf16* qr = Q + tok * 1024 + h * HD + 8 * hf;
#pragma unroll
      for (int ks = 0; ks < 8; ++ks) qf[ks] = *(const bf16x8*)(qr + 16 * ks); }
    const float lg2 = (BR == 0) ? __log2f(1.0f - exp2f(-5.0f - (float)h)) : 0.f;
    const int kkey = tid >> 3, kc = tid & 7, vd = tid >> 2, vc = tid & 3;
    const bf16* kbase = Kx + ((size_t)b * S_ + kkey) * 1024 + h * HD + 8 * kc;
    const bf16* vbase = VT + (size_t)(BR * 1024 + h * HD + vd) * NTOK + (size_t)b * S_ + 16 * vc;
#define ATT_LOAD(T, jt) do { const int s0_ = (jt) * 64; const bf16* kr_ = kbase + (size_t)s0_ * 1024; T.ka = *(const u32x4*)kr_; T.kb = *(const u32x4*)(kr_ + 64); \
        T.va = *(const u32x4*)(vbase + s0_); T.vb = *(const u32x4*)(vbase + s0_ + 8); } while (0)
#define ATT_STORE(T, buf, KA, KB) do { LAS unsigned char* kd_ = lds + (buf) * KBUF + kkey * KS_ + 16 * kc; *(LAS u32x4*)kd_ = (KA); *(LAS u32x4*)(kd_ + 128) = (KB); \
        LAS unsigned char* vp_ = lds + 2 * KBUF + (buf) * VBUF + vd * VS_ + 32 * vc; \
        *(LAS u32x2*)vp_ = (u32x2){T.va.x, T.va.y}; *(LAS u32x2*)(vp_ + 8) = (u32x2){T.va.z, T.va.w}; *(LAS u32x2*)(vp_ + 16) = (u32x2){T.vb.x, T.vb.y}; *(LAS u32x2*)(vp_ + 24) = (u32x2){T.vb.z, T.vb.w}; } while (0)

    f32x16 oT[4];
#pragma unroll
    for (int dt = 0; dt < 4; ++dt)
#pragma unroll
        for (int i = 0; i < 16; ++i) oT[dt][i] = 0.f;
    Tile ta, tb;
    if (BR == 0 && qb > 0) {
        f32x16 Racc[2];
#pragma unroll
        for (int i = 0; i < 16; ++i) { Racc[0][i] = 0.f; Racc[1][i] = 0.f; }
        const int i16 = lane & 15, tq_ = i16 >> 2, tp_ = i16 & 3, tblk = (lane >> 4) & 1;
        const int ka_off = (8 * hf + tq_) * KS_ + 64 * (wave >> 1) + 8 * (4 * tblk + tp_);
        const int vb_off = (64 * (wave & 1) + r32) * VS_ + 16 * hf;
#define P1_STORE(T, buf, jt) do { const float dec_ = __builtin_amdgcn_exp2f((float)(t0 - (jt) * 64 - kkey) * lg2); const u32x4 ka_ = scale8(T.ka, dec_), kb_ = scale8(T.kb, dec_); ATT_STORE(T, buf, ka_, kb_); } while (0)
#define P1_COMPUTE(buf) do { const LAS unsigned char* kimg = lds + (buf) * KBUF + ka_off; const LAS unsigned char* vimg = lds + 2 * KBUF + (buf) * VBUF + vb_off; \
            _Pragma("unroll") for (int ks = 0; ks < 4; ++ks) { \
                const s16x4 alo = __builtin_amdgcn_ds_read_tr16_b64_v4i16((LAS s16x4*)(kimg + 16 * ks * KS_)), ahi = __builtin_amdgcn_ds_read_tr16_b64_v4i16((LAS s16x4*)(kimg + (16 * ks + 4) * KS_)); \
                const bf16x8 a = __builtin_shufflevector(alo, ahi, 0, 1, 2, 3, 4, 5, 6, 7); \
                _Pragma("unroll") for (int tt = 0; tt < 2; ++tt) { const u32x2 lo = *(const LAS u32x2*)(vimg + tt * 32 * VS_ + 32 * ks), hi = *(const LAS u32x2*)(vimg + tt * 32 * VS_ + 32 * ks + 8); \
                    const bf16x8 bb = __builtin_bit_cast(bf16x8, (u32x4){lo.x, lo.y, hi.x, hi.y}); Racc[tt] = __builtin_amdgcn_mfma_f32_32x32x16_bf16(a, bb, Racc[tt], 0, 0, 0); } } } while (0)
        const int np = 4 * qb;
        ATT_LOAD(ta, 0); ATT_LOAD(tb, 1);
        for (int jt = 0; jt < np; jt += 2) {
            P1_STORE(ta, 0, jt);
            __syncthreads();
            if (jt + 2 < np) ATT_LOAD(ta, jt + 2);
            P1_COMPUTE(0);
            P1_STORE(tb, 1, jt + 1);
            __syncthreads();
            if (jt + 3 < np) ATT_LOAD(tb, jt + 3);
            P1_COMPUTE(1);
        }
#undef P1_STORE
#undef P1_COMPUTE
#pragma unroll
        for (int tt = 0; tt < 2; ++tt) { LAS unsigned char* rp = lds + RT_OFF + (32 * (2 * (wave & 1) + tt) + r32) * RTS + (32 * (wave >> 1) + 4 * hf) * 2;
#pragma unroll
            for (int g = 0; g < 4; ++g) *(LAS u32x2*)(rp + 16 * g) = (u32x2){pg8::cvt_pk_bf16(Racc[tt][4 * g], Racc[tt][4 * g + 1]), pg8::cvt_pk_bf16(Racc[tt][4 * g + 2], Racc[tt][4 * g + 3])}; }
        __syncthreads();
        const LAS unsigned char* rb = lds + RT_OFF + r32 * RTS + 16 * hf;
#pragma unroll
        for (int dt = 0; dt < 4; ++dt)
#pragma unroll
            for (int ks = 0; ks < 8; ++ks) { const bf16x8 a = *(const LAS bf16x8*)(rb + dt * 32 * RTS + 32 * ks); oT[dt] = __builtin_amdgcn_mfma_f32_32x32x16_bf16(a, qf[ks], oT[dt], 0, 0, 0); }
        const float sc = __builtin_amdgcn_exp2f((float)(t - t0) * lg2);
#pragma unroll
        for (int dt = 0; dt < 4; ++dt)
#pragma unroll
            for (int i = 0; i < 16; ++i) oT[dt][i] *= sc;
    }
    float carry = 0.f; bool wdone = false;
    LAS int* flg = (LAS int*)(lds + 2 * KBUF + 2 * VBUF);
    const int last = 4 * qb + 3;
    const int jmin = (BR == 0) ? 4 * qb : 0;
    ATT_LOAD(ta, last);
    for (int jt = last, it = 0; jt >= jmin; --jt, ++it) {
        const int buf = it & 1;
        ATT_STORE(ta, buf, ta.ka, ta.kb);
        __syncthreads();
        if (BR == 1 && it > 0) {
            int all = 1;
#pragma unroll
            for (int w8 = 0; w8 < 8; ++w8) all &= flg[((it - 1) & 1) * 8 + w8];
            if (all) break;
        }
        if (jt > jmin) ATT_LOAD(ta, jt - 1);
        const int s0 = jt * 64;
        if (s0 <= tw0 + 31 && !wdone) {
            const int tq = t - s0 - 4 * hf;
            bf16x8 pf[4];
            const LAS unsigned char* kb_ = lds + buf * KBUF + r32 * KS_ + 16 * hf;
#pragma unroll
            for (int kk = 0; kk < 2; ++kk) {
                const int kt = 1 - kk;
                f32x16 sT;
#pragma unroll
                for (int i = 0; i < 16; ++i) sT[i] = 0.f;
#pragma unroll
                for (int ks = 0; ks < 8; ++ks) { const bf16x8 a = *(const LAS bf16x8*)(kb_ + kt * 32 * KS_ + 32 * ks); sT = __builtin_amdgcn_mfma_f32_32x32x16_bf16(a, qf[ks], sT, 0, 0, 0); }
                float w[16];
                if (BR == 1) {
#pragma unroll
                    for (int gg = 0; gg < 4; ++gg) {
                        const int g = 3 - gg;
                        float lf[4], ls[4]; bool vd_[4];
#pragma unroll
                        for (int e = 0; e < 4; ++e) {
                            const float z2 = __builtin_amdgcn_fmed3f(sT[4 * g + e] * C2, -126.f, 126.f);
                            const float ex = __builtin_amdgcn_exp2f(z2); const float sp = __builtin_amdgcn_logf(1.0f + ex);
                            vd_[e] = (32 * kt + 8 * g + e) < tq; lf[e] = vd_[e] ? -sp : 0.f; ls[e] = z2 - sp;
                        }
                        const float s2 = lf[3], s1 = s2 + lf[2], s0x = s1 + lf[1], T = s0x + lf[0];
                        const float Tp = __shfl_xor(T, 32);
                        const float off = carry + (hf == 0 ? Tp : 0.f);
                        w[4 * g + 3] = vd_[3] ? __builtin_amdgcn_exp2f(ls[3] + off) : 0.f;
                        w[4 * g + 2] = vd_[2] ? __builtin_amdgcn_exp2f(ls[2] + (off + s2)) : 0.f;
                        w[4 * g + 1] = vd_[1] ? __builtin_amdgcn_exp2f(ls[1] + (off + s1)) : 0.f;
                        w[4 * g + 0] = vd_[0] ? __builtin_amdgcn_exp2f(ls[0] + (off + s0x)) : 0.f;
                        carry += T + Tp;
                    }
                } else {
                    const float basef = (float)tq * lg2;
#pragma unroll
                    for (int r = 0; r < 16; ++r) { const int c = 32 * kt + 8 * (r >> 2) + (r & 3);
                        const float dec = __builtin_amdgcn_exp2f(basef - (float)c * lg2);
                        w[r] = (c <= tq) ? sT[r] * dec : 0.f; }
                }
                float w0[8], w1[8];
#pragma unroll
                for (int j = 0; j < 8; ++j) { w0[j] = w[j]; w1[j] = w[8 + j]; }
                pf[2 * kt] = __builtin_bit_cast(bf16x8, pack8(w0)); pf[2 * kt + 1] = __builtin_bit_cast(bf16x8, pack8(w1));
            }
            const LAS unsigned char* vb_ = lds + 2 * KBUF + buf * VBUF + r32 * VS_ + 8 * hf;
#pragma unroll
            for (int dt = 0; dt < 4; ++dt)
#pragma unroll
                for (int sp = 0; sp < 4; ++sp) {
                    const u32x2 lo = *(const LAS u32x2*)(vb_ + dt * 32 * VS_ + 32 * sp), hi = *(const LAS u32x2*)(vb_ + dt * 32 * VS_ + 32 * sp + 16);
                    const bf16x8 a = __builtin_bit_cast(bf16x8, (u32x4){lo.x, lo.y, hi.x, hi.y});
                    oT[dt] = __builtin_amdgcn_mfma_f32_32x32x16_bf16(a, pf[sp], oT[dt], 0, 0, 0);
                }
            if (BR == 1) wdone = __all(carry <= -150.0f) != 0;
        }
        if (BR == 1 && lane == 0) flg[(it & 1) * 8 + wave] = wdone ? 1 : 0;
    }
#undef ATT_LOAD
#undef ATT_STORE
    if (BR == 0) {
        float s = 0.f;
#pragma unroll
        for (int dt = 0; dt < 4; ++dt)
#pragma unroll
            for (int i = 0; i < 16; ++i) s += oT[dt][i];
        s += __shfl_xor(s, 32);
        const float mean = s * (1.0f / 128.0f); float q = 0.f;
#pragma unroll
        for (int dt = 0; dt < 4; ++dt)
#pragma unroll
            for (int i = 0; i < 16; ++i) { const float d = oT[dt][i] - mean; q += d * d; }
        q += __shfl_xor(q, 32);
        const float rstd = 1.0f / sqrtf(q * (1.0f / 128.0f) + LN_EPS);
        const bf16* gr = RG + tok * 1024 + h * HD + 4 * hf; const bf16* gr1 = RG1 + tok * 1024 + h * HD + 4 * hf; bf16* orow = O + tok * D_ + h * HD + 4 * hf;
#pragma unroll
        for (int dt = 0; dt < 4; ++dt)
#pragma unroll
            for (int g = 0; g < 4; ++g) { const int d = 32 * dt + 8 * g;
                const u32x2 gw = *(const u32x2*)(gr + d), gx = *(const u32x2*)(gr1 + d);
                const float g0 = __builtin_bit_cast(float, gw.x << 16) + __builtin_bit_cast(float, gx.x << 16), g1 = __builtin_bit_cast(float, gw.x & 0xffff0000u) + __builtin_bit_cast(float, gx.x & 0xffff0000u);
                const float g2 = __builtin_bit_cast(float, gw.y << 16) + __builtin_bit_cast(float, gx.y << 16), g3 = __builtin_bit_cast(float, gw.y & 0xffff0000u) + __builtin_bit_cast(float, gx.y & 0xffff0000u);
                const float o0 = (oT[dt][4 * g] - mean) * rstd * (g0 * pg8::sig_(g0)), o1 = (oT[dt][4 * g + 1] - mean) * rstd * (g1 * pg8::sig_(g1));
                const float o2 = (oT[dt][4 * g + 2] - mean) * rstd * (g2 * pg8::sig_(g2)), o3 = (oT[dt][4 * g + 3] - mean) * rstd * (g3 * pg8::sig_(g3));
                *(u32x2*)(orow + d) = (u32x2){pg8::cvt_pk_bf16(o0, o1), pg8::cvt_pk_bf16(o2, o3)}; }
    } else {
        bf16* orow = O + tok * D_ + 1024 + h * HD + 4 * hf;
#pragma unroll
        for (int dt = 0; dt < 4; ++dt)
#pragma unroll
            for (int g = 0; g < 4; ++g) { const int d = 32 * dt + 8 * g;
                *(u32x2*)(orow + d) = (u32x2){pg8::cvt_pk_bf16(oT[dt][4 * g], oT[dt][4 * g + 1]), pg8::cvt_pk_bf16(oT[dt][4 * g + 2], oT[dt][4 * g + 3])}; }
    }
    __syncthreads();
}
}

constexpr int PH_PER_LAYER = 9, N_PHASES = 1 + DEPTH * PH_PER_LAYER;
struct FArgs { const float* in[21]; float* out; unsigned char* ws; int ph_lo, ph_hi, li, pad; };
typedef const __attribute__((address_space(4))) FArgs* KArgP;
DI KArgP kargs() { KArgP p = (KArgP)__builtin_amdgcn_kernarg_segment_ptr(); asm volatile("" : "+s"(p)); return p; }


#define IN(k) (lo <= (k) && (k) < hi)
#define SEAM(k) do { if (IN(k) && IN((k) + 1)) xcd_barrier(bar); } while (0)
#define PHASE_IDS() int tid = threadIdx.x; asm volatile("" : "+v"(tid)); const int lane = tid & 63, wave = __builtin_amdgcn_readfirstlane(tid >> 6), gw = vcu * 8 + wave; (void)lane; (void)gw
#define cosT ((float*)(ws + WS_ROT))
#define sinT ((float*)(ws + WS_ROT) + S_ * 64)
#define XB ((bf16*)(ws + WS_XB))
#define PB ((bf16*)(ws + WS_PB))
#define H5 ((bf16*)(ws + WS_H5))
#define VT ((bf16*)(ws + WS_VT))
#define GATES ((bf16*)(ws + WS_GATES))
#define O ((bf16*)(ws + WS_O))
#define T1 ((float*)(ws + WS_T1))
#define MERGED ((bf16*)(ws + WS_MERGED))
#define Yb ((bf16*)(ws + WS_Y))
#define X1B ((bf16*)(ws + WS_X1B))
#define PLEB ((bf16*)(ws + WS_PLE))
#define PWB ((bf16*)(ws + WS_PW))
#define HMID ((bf16*)(ws + WS_HMID))
#define XS ((bf16*)(ws + WS_XS))
#define YE2 ((bf16*)(ws + WS_XS))
#define tope ((int*)(ws + WS_MOE + MO_TOPE))
#define topg ((float*)(ws + WS_MOE + MO_TOPG))
#define pos ((int*)(ws + WS_MOE + MO_POS))
#define blk_e ((int*)(ws + WS_MOE + MO_BLKE))
#define meta ((int*)(ws + WS_MOE + MO_META))
template <int l>
DI void layer_body(LAS unsigned char* lds, const XcdBarrier& bar, const int lo, const int hi, const int G, const int vcu) {
    const int NGW = G * 8; const int bid = (int)blockIdx.x;
#define PHASE_WS() unsigned char* const ws = kargs()->ws
    const size_t SLOT = (size_t)NTOK * 1024;

        const int pb = 1 + l * PH_PER_LAYER;
        const bool moe = (l & 1) != 0;
#define WIN ((const bf16*)(ws + WS_WIN) + (size_t)l * 11264 * D_)

        if (IN(pb + 0)) {
            PHASE_WS();
#ifndef PA_PARTS
#define PA_PARTS 7
#endif
            if (PA_PARTS & 1) { pg8::Gemm g{XB, WIN, D_, D_, D_}; pg8::SchedA1 S{G, bid}; pg8::EpiA1 E{H5, GATES, kargs()->in[6] + (size_t)l * 4096, cosT, sinT};
              pg8::gemm_phase<pg8::EpiA1, pg8::SchedA1, true>(lds, g, S, E); }
            { pg8::Gemm g{(const bf16*)(ws + WS_XB8), (const bf16*)(ws + WS_WG8 + (size_t)l * 4096 * D_), D_ / 2, D_ / 2, D_ / 2};
              pg8::SchedPlain S{NTOK / 256, 4096 / 256, G, bid, (size_t)256 * D_, (size_t)256 * D_}; pg8::EpiGate8 E{GATES, kargs()->in[6] + (size_t)l * 4096};
              pg8::gemm_phase<pg8::EpiGate8, pg8::SchedPlain, true, true>(lds, g, S, E); }
            if (PA_PARTS & 2) { pg8::Gemm g{WIN, XB, D_, D_, D_}; pg8::SchedVT S{G, bid}; pg8::EpiBf16 E{VT, NTOK};
              pg8::gemm_phase<pg8::EpiBf16, pg8::SchedVT, true>(lds, g, S, E); }
            { pg8::Gemm g{XB, WIN, D_, D_, D_ / 2}; pg8::SchedRG S{G, bid}; pg8::EpiRG E{H5 + 2 * SLOT, (bf16*)(ws + WS_RG1)};
              pg8::gemm_phase<pg8::EpiRG, pg8::SchedRG, true>(lds, g, S, E); }
            if (PA_PARTS & 4) { pg8::Gemm g{PB + (size_t)l * NTOK * PLED, (const bf16*)(ws + WS_WP) + (size_t)l * D_ * PLED, PLED, PLED, PLED};
              pg8::SchedPlain S{NTOK / 256, D_ / 256, G, bid, (size_t)256 * PLED * 2, (size_t)256 * PLED * 2}; pg8::EpiBf16 E{PWB, D_};
              pg8::gemm_phase<pg8::EpiBf16, pg8::SchedPlain, true>(lds, g, S, E); }
        }
        SEAM(pb + 0);
        if (IN(pb + 1)) {
            PHASE_WS();
            const bf16 *RQ = H5, *RK = H5 + SLOT, *RG = H5 + 2 * SLOT, *SQ = H5 + 3 * SLOT, *SK = H5 + 4 * SLOT, *RG1 = (const bf16*)(ws + WS_RG1);
            LAS int* uq = (LAS int*)(lds + LDSCTL_OFF + 2048);
            unsigned* qctr = (unsigned*)(ws + WS_CTL) + (size_t)(kargs()->li * DEPTH + l) * 8 * 32;
            const int q0 = (int)(((unsigned)vcu * 8u) / (unsigned)G) & 7;
            for (int k = 0; k < 8; ++k) {
                const int q = (q0 + k) & 7;
                for (;;) {
                    if (threadIdx.x == 0) *uq = (int)atomicAdd(qctr + q * 32, 1u);
                    __syncthreads();
                    const int u = __builtin_amdgcn_readfirstlane(*uq);
                    __syncthreads();
                    if (u >= 64) break;
                    const int code = (int)((0x89ABCDEF01234567ull >> (4 * (u >> 2))) & 15ull);
                    const int bh = q * 4 + (u & 3), b = bh >> 3, h = bh & 7, qb = code & 7;
                    if (code & 8) att::unit<1>(lds, SQ, SK, VT, RG, RG1, O, b, h, qb);
                    else att::unit<0>(lds, RQ, RK, VT, RG, RG1, O, b, h, qb);
                }
            }
        }
        SEAM(pb + 1);
        if (IN(pb + 2)) {
            PHASE_WS();
            pg8::Gemm g{O, (const bf16*)(ws + WS_WBR) + (size_t)l * D_ * D_, D_, D_, D_};
            pg8::SchedPlain S{NTOK / 256, D_ / 256, G, bid, (size_t)256 * D_ * 2, (size_t)256 * D_ * 2}; pg8::EpiMerge E{GATES, MERGED};
            pg8::gemm_phase<pg8::EpiMerge, pg8::SchedPlain, true>(lds, g, S, E);
        }
        SEAM(pb + 2);
        if (IN(pb + 3)) {
            PHASE_WS();
            pg8::Gemm g{MERGED, (const bf16*)(ws + WS_WO) + (size_t)l * D_ * D_, D_, D_, D_};
            pg8::SchedPlain S{NTOK / 256, D_ / 256, G, bid, (size_t)256 * D_ * 2, (size_t)256 * D_ * 2}; pg8::EpiYb<false> E{XB, nullptr, Yb};
            pg8::gemm_phase<pg8::EpiYb<false>, pg8::SchedPlain, true>(lds, g, S, E);
        }
        SEAM(pb + 3);
        if (IN(pb + 4)) {
            PHASE_WS();
            PHASE_IDS();
            const float* g1 = kargs()->in[8] + (size_t)l * D_; const float* b1 = kargs()->in[9] + (size_t)l * D_;
            if (!moe) { for (int row = gw; row < NTOK; row += NGW) ln_row<false, false>(row, lane, Yb, g1, b1, nullptr, X1B, nullptr, (const LAS float*)nullptr, nullptr, nullptr, nullptr, nullptr, nullptr, nullptr); }
            else { const float* wr = kargs()->in[13] + (size_t)(l / 2) * D_ * NE; LAS float* wT = (LAS float*)lds;
                for (int c = tid; c < D_; c += 512) { const f32x4 a = *(const f32x4*)(wr + (size_t)c * 8), b = *(const f32x4*)(wr + (size_t)c * 8 + 4);
                    LAS float* wp = wT + ((c >> 2) & 1) * 1024 + ((c >> 9) * 64 + ((c >> 3) & 63)) * 4 + (c & 3);
                    wp[0] = a[0]; wp[2048] = a[1]; wp[2 * 2048] = a[2]; wp[3 * 2048] = a[3]; wp[4 * 2048] = b[0]; wp[5 * 2048] = b[1]; wp[6 * 2048] = b[2]; wp[7 * 2048] = b[3]; }
                __syncthreads();
                for (int row = gw; row < NTOK; row += NGW) ln_row<true, false>(row, lane, Yb, g1, b1, nullptr, X1B, nullptr, wT, tope, topg, nullptr, nullptr, nullptr, nullptr);
                __syncthreads(); }
        }
        SEAM(pb + 4);
        if (IN(pb + 5) && moe) {
            PHASE_WS();
            PHASE_IDS();
            LAS int* cnt = (LAS int*)lds;
            LAS int* tot = (LAS int*)(lds + 16384);
            LAS int* dl = (LAS int*)(lds + 16384 + 64);
            LAS unsigned char* eb = lds + 32768;
            {
                const u32x4* tp = (const u32x4*)(tope + 32 * tid); u32x4 tv[8];
#pragma unroll
                for (int q = 0; q < 8; ++q) tv[q] = tp[q];
                int c0 = 0, c1 = 0, c2 = 0, c3 = 0, c4 = 0, c5 = 0, c6 = 0, c7 = 0;
#pragma unroll
                for (int q = 0; q < 8; ++q) { const unsigned ev[4] = {tv[q].x, tv[q].y, tv[q].z, tv[q].w};
#pragma unroll
                    for (int k = 0; k < 4; ++k) { const unsigned e = ev[k]; c0 += (e == 0u); c1 += (e == 1u); c2 += (e == 2u); c3 += (e == 3u); c4 += (e == 4u); c5 += (e == 5u); c6 += (e == 6u); c7 += (e == 7u); }
                    *(LAS unsigned*)(eb + 32 * tid + 4 * q) = ev[0] | (ev[1] << 8) | (ev[2] << 16) | (ev[3] << 24); }
                LAS int* cr = cnt + tid * 8; cr[0] = c0; cr[1] = c1; cr[2] = c2; cr[3] = c3; cr[4] = c4; cr[5] = c5; cr[6] = c6; cr[7] = c7;
            }
            __syncthreads();
            {
                const int e = wave; int loc[8]; int sum = 0;
#pragma unroll
                for (int q = 0; q < 8; ++q) { loc[q] = cnt[(8 * lane + q) * 8 + e]; sum += loc[q]; }
                int incl = sum;
#pragma unroll
                for (int o = 1; o < 64; o <<= 1) { const int v = __shfl_up(incl, o); if (lane >= o) incl += v; }
                int run = incl - sum;
#pragma unroll
                for (int q = 0; q < 8; ++q) { cnt[(8 * lane + q) * 8 + e] = run; run += loc[q]; }
                if (lane == 63) tot[e] = incl;
            }
            __syncthreads();
            if (tid == 0) { int off = 0, nb = 0; for (int e = 0; e < 8; ++e) { tot[8 + e] = off; const int nbl = (tot[e] + 255) >> 8; if (bid == 0) for (int q = 0; q < nbl; ++q) blk_e[nb + q] = e; nb += nbl; off += nbl * 256; }
                if (bid == 0) { meta[0] = nb; for (int q = nb; q < MOE_P / 256; ++q) blk_e[q] = NE - 1; } }
            __syncthreads();
            for (int sl = vcu; sl < 256; sl += G) {
                if (tid < 64) {
                    const int f = 64 * sl + tid, chunk = f >> 5, j = f & 31; const unsigned e = eb[f]; int rank = 0;
                    for (int jj = 0; jj < j; ++jj) rank += (eb[32 * chunk + jj] == e);
                    const int dest = tot[8 + e] + cnt[chunk * 8 + e] + rank;
                    pos[f] = dest; dl[tid] = dest; dl[64 + tid] = f >> 1;
                }
                __syncthreads();
                for (int r = wave; r < 64; r += 8) { const int dest = dl[r], tk = dl[64 + r];
                    const u32x4* s = (const u32x4*)(X1B + (size_t)tk * D_); u32x2* d = (u32x2*)((unsigned char*)XS + (size_t)dest * D_);
#pragma unroll
                    for (int q = 0; q < 4; ++q) { const u32x4 w = s[lane + 64 * q]; float x[8]; att::unpack8(w, x);
                        d[lane + 64 * q] = (u32x2){pg8::pk4_fp8(x[0] * X_SC, x[1] * X_SC, x[2] * X_SC, x[3] * X_SC), pg8::pk4_fp8(x[4] * X_SC, x[5] * X_SC, x[6] * X_SC, x[7] * X_SC)}; } }
                __syncthreads();
            }
        }
        if (moe) SEAM(pb + 5);
        if (IN(pb + 6)) {
            PHASE_WS();
            if (!moe) { pg8::Gemm g{X1B, (const bf16*)(ws + WS_WF1), D_, D_, D_}; pg8::SchedPlain S{NTOK / 256, 2 * DFF / 256, G, bid, (size_t)256 * D_ * 2, (size_t)256 * D_ * 2}; pg8::EpiSwi E{HMID, DFF};
                pg8::gemm_phase<pg8::EpiSwi, pg8::SchedPlain, true>(lds, g, S, E); }
            else { const int nblk = __builtin_amdgcn_readfirstlane(meta[0]);
                LAS int* etab = (LAS int*)(lds + LDSCTL_OFF + 1024); if (threadIdx.x < MOE_P / 256) etab[threadIdx.x] = blk_e[threadIdx.x]; __syncthreads();
                pg8::Gemm g{XS, (const bf16*)(ws + WS_WM1), D_ / 2, D_ / 2, D_ / 2}; pg8::SchedMoe S{etab, nblk, 2 * DFFE / 256, G, bid, (size_t)256 * D_, (size_t)256 * D_, (size_t)2 * DFFE * D_};
                pg8::EpiSwi8 E{(unsigned char*)HMID, DFFE};
                pg8::gemm_phase<pg8::EpiSwi8, pg8::SchedMoe, true, true>(lds, g, S, E); }
            if (!moe) { pg8::Gemm g{X1B, (const bf16*)(ws + WS_WG) + (size_t)l * D_ * D_, D_, D_, D_}; pg8::SchedPlain S{NTOK / 256, D_ / 256, G, bid, (size_t)256 * D_ * 2, (size_t)256 * D_ * 2}; pg8::EpiPleB E{PWB, PLEB};
              pg8::gemm_phase<pg8::EpiPleB, pg8::SchedPlain, true>(lds, g, S, E); }
        }
        SEAM(pb + 6);
        if (IN(pb + 7)) {
            PHASE_WS();
            if (!moe) { pg8::Gemm g{HMID, (const bf16*)(ws + WS_WF2), DFF, DFF, DFF}; pg8::SchedPlain S{NTOK / 256, D_ / 256, G, bid, (size_t)256 * DFF * 2, (size_t)256 * DFF * 2}; pg8::EpiYb<true> E{X1B, PLEB, Yb};
                pg8::gemm_phase<pg8::EpiYb<true>, pg8::SchedPlain, true>(lds, g, S, E); }
            else { const int nblk = __builtin_amdgcn_readfirstlane(meta[0]);
                LAS int* etab = (LAS int*)(lds + LDSCTL_OFF + 1024); if (threadIdx.x < MOE_P / 256) etab[threadIdx.x] = blk_e[threadIdx.x]; __syncthreads();
                { pg8::Gemm g{HMID, (const bf16*)(ws + WS_WM2), DFFE / 2, DFFE / 2, DFFE / 4}; pg8::SchedMoe2 S{etab, nblk, G, bid}; pg8::EpiYE2 E{YE2};
                  pg8::gemm_phase<pg8::EpiYE2, pg8::SchedMoe2, true, true>(lds, g, S, E); }
                { const int r0 = (nblk * 16) % G;
                  pg8::Gemm g{X1B, (const bf16*)(ws + WS_WG) + (size_t)l * D_ * D_, D_, D_, D_}; pg8::SchedTail S{NTOK / 256, D_ / 256, G, bid, r0, (size_t)256 * D_ * 2, (size_t)256 * D_ * 2}; pg8::EpiPleB E{PWB, PLEB};
                  pg8::gemm_phase<pg8::EpiPleB, pg8::SchedTail, true>(lds, g, S, E); } }
        }
        SEAM(pb + 7);
        if (IN(pb + 8)) {
            PHASE_WS();
            PHASE_IDS();
            const float* g2 = kargs()->in[19] + (size_t)l * D_; const float* b2 = kargs()->in[20] + (size_t)l * D_;
            float* const xout_ = (l == DEPTH - 1) ? kargs()->out : (float*)nullptr;
            bf16* const xb_ = (l == DEPTH - 1) ? (bf16*)nullptr : XB; unsigned char* const xb8_ = (l == DEPTH - 1) ? (unsigned char*)nullptr : (unsigned char*)(ws + WS_XB8);
            if (!moe) { for (int row = gw; row < NTOK; row += NGW) ln_row<false, false>(row, lane, Yb, g2, b2, xout_, xb_, xb8_, (const LAS float*)nullptr, nullptr, nullptr, nullptr, nullptr, nullptr, nullptr); }
            else { for (int row = gw; row < NTOK; row += NGW) ln_row<false, true>(row, lane, nullptr, g2, b2, xout_, xb_, xb8_, (const LAS float*)nullptr, nullptr, topg, X1B, YE2, pos, PLEB); }
        }
        SEAM(pb + 8);
    }

#undef cosT
#undef sinT
#undef XB
#undef PB
#undef H5
#undef VT
#undef GATES
#undef O
#undef T1
#undef MERGED
#undef Yb
#undef X1B
#undef PLEB
#undef PWB
#undef HMID
#undef XS
#undef YE2
#undef tope
#undef topg
#undef pos
#undef blk_e
#undef meta
#undef WIN
#undef PHASE_WS
__global__ void __launch_bounds__(512, 2) mk_fwd(FArgs args) {
    extern __shared__ __attribute__((aligned(16))) unsigned char lds_raw[];
    LAS unsigned char* lds = (LAS unsigned char*)lds_raw;
    volatile LAS unsigned* MISC = (volatile LAS unsigned*)(lds + MISC_OFF);
    const int G = gridDim.x; int vcu; { const int bx = blockIdx.x; vcu = (G % 8 == 0) ? (bx % 8) * (G / 8) + bx / 8 : bx; }
    unsigned char* const ws = kargs()->ws;
    unsigned* ctl = (unsigned*)(ws + WS_CTL);
    for (int u = threadIdx.x; u < (LDS_BYTES - LDSCTL_OFF) / 4; u += 512) ((LAS unsigned*)(lds + LDSCTL_OFF))[u] = 0u;
    __syncthreads();
    XcdBarrier bar = xcd_barrier_post(ctl + CW_BAR + kargs()->li * XCD_BAR_WORDS, MISC + 8);
    const int lo = kargs()->ph_lo, hi = kargs()->ph_hi;
    const int NGW = G * 8;
    const int bid = (int)blockIdx.x;

    float* cosT = (float*)(ws + WS_ROT); float* sinT = cosT + S_ * 64;
    bf16* XB = (bf16*)(ws + WS_XB); bf16* PB = (bf16*)(ws + WS_PB); bf16* H5 = (bf16*)(ws + WS_H5); bf16* VT = (bf16*)(ws + WS_VT); bf16* GATES = (bf16*)(ws + WS_GATES);
    bf16* O = (bf16*)(ws + WS_O); float* T1 = (float*)(ws + WS_T1); bf16* MERGED = (bf16*)(ws + WS_MERGED); float* Y = (float*)(ws + WS_Y); float* X1 = (float*)(ws + WS_X1);
    bf16* X1B = (bf16*)(ws + WS_X1B); float* X2 = (float*)(ws + WS_X2); float* PLE = (float*)(ws + WS_PLE); float* PW = (float*)(ws + WS_PW); bf16* HMID = (bf16*)(ws + WS_HMID);
    bf16* XS = (bf16*)(ws + WS_XS); bf16* YE2 = (bf16*)(ws + WS_XS);
    int* tope = (int*)(ws + WS_MOE + MO_TOPE); float* topg = (float*)(ws + WS_MOE + MO_TOPG); int* pos = (int*)(ws + WS_MOE + MO_POS);
    int* blk_e = (int*)(ws + WS_MOE + MO_BLKE); int* meta = (int*)(ws + WS_MOE + MO_META);
    const size_t SLOT = (size_t)NTOK * 1024;

    if (IN(0)) {
        PHASE_IDS();
        LAS unsigned* T = (LAS unsigned*)(lds + wave * 16384);
        int rot = 0;
        for (int l = 0; l < DEPTH; ++l) {
            bf16* WIN = (bf16*)(ws + WS_WIN) + (size_t)l * 11264 * D_;
            cvt_seg(CvtSeg{kargs()->in[2] + (size_t)l * D_ * INW, WIN, 1, D_, INW, 2048, 3, D_, 0}, rot, gw, NGW, T, lane);
            cvt_seg(CvtSeg{kargs()->in[2] + (size_t)l * D_ * INW + 2048, WIN + (size_t)2048 * D_, 1, D_, INW, INW - 2048, 0, D_, 0}, rot, gw, NGW, T, lane);
            cvt_seg8(CvtSeg{kargs()->in[5] + (size_t)l * D_ * 4096, (bf16*)(ws + WS_WG8 + (size_t)l * 4096 * D_), 1, D_, 4096, 4096, 0, D_, 0}, W13_SC, rot, gw, NGW, T, lane);
            cvt_seg(CvtSeg{kargs()->in[3] + (size_t)l * RW * D_, (bf16*)(ws + WS_WBR) + (size_t)l * D_ * D_, 1, RW, D_, D_, 0, D_, 0}, rot, gw, NGW, T, lane);
            cvt_seg(CvtSeg{kargs()->in[4] + (size_t)l * RW * D_, (bf16*)(ws + WS_WBR) + (size_t)l * D_ * D_, 1, RW, D_, D_, 0, D_, RW}, rot, gw, NGW, T, lane);
            cvt_seg(CvtSeg{kargs()->in[7] + (size_t)l * D_ * D_, (bf16*)(ws + WS_WO) + (size_t)l * D_ * D_, 1, D_, D_, D_, 0, D_, 0}, rot, gw, NGW, T, lane);
            cvt_seg(CvtSeg{kargs()->in[17] + (size_t)l * PLED * D_, (bf16*)(ws + WS_WP) + (size_t)l * D_ * PLED, 1, PLED, D_, D_, 0, PLED, 0}, rot, gw, NGW, T, lane);
            cvt_seg(CvtSeg{kargs()->in[18] + (size_t)l * D_ * D_, (bf16*)(ws + WS_WG) + (size_t)l * D_ * D_, 1, D_, D_, D_, 0, D_, 0}, rot, gw, NGW, T, lane);
        }
        cvt_seg(CvtSeg{kargs()->in[10], (bf16*)(ws + WS_WF1), 1, D_, DFF, DFF, 1, D_, 0}, rot, gw, NGW, T, lane);
        cvt_seg(CvtSeg{kargs()->in[11], (bf16*)(ws + WS_WF1), 1, D_, DFF, DFF, 2, D_, 0}, rot, gw, NGW, T, lane);
        cvt_seg(CvtSeg{kargs()->in[12], (bf16*)(ws + WS_WF2), 1, DFF, D_, D_, 0, DFF, 0}, rot, gw, NGW, T, lane);
        cvt_seg8(CvtSeg{kargs()->in[14], (bf16*)(ws + WS_WM1), NE, D_, DFFE, DFFE, 1, D_, 0}, W13_SC, rot, gw, NGW, T, lane);
        cvt_seg8(CvtSeg{kargs()->in[15], (bf16*)(ws + WS_WM1), NE, D_, DFFE, DFFE, 2, D_, 0}, W13_SC, rot, gw, NGW, T, lane);
        cvt_seg8(CvtSeg{kargs()->in[16], (bf16*)(ws + WS_WM2), NE, DFFE, D_, D_, 0, DFFE, 0}, W2_SC, rot, gw, NGW, T, lane);
        { const size_t n4 = (size_t)NTOK * D_ / 4; const f32x4* s = (const f32x4*)kargs()->in[0]; u32x2* d = (u32x2*)XB;
          unsigned* d8 = (unsigned*)(ws + WS_XB8);
          for (size_t i = (size_t)bid * 512 + tid; i < n4; i += (size_t)G * 512) { const f32x4 v = s[i]; d[i] = (u32x2){pg8::cvt_pk_bf16(v.x, v.y), pg8::cvt_pk_bf16(v.z, v.w)}; d8[i] = pg8::pk4_fp8(v.x * X_SC, v.y * X_SC, v.z * X_SC, v.w * X_SC); } }
        { const size_t n4 = (size_t)DEPTH * NTOK * PLED / 4; const f32x4* s = (const f32x4*)kargs()->in[1]; u32x2* d = (u32x2*)PB;
          for (size_t i = (size_t)bid * 512 + tid; i < n4; i += (size_t)G * 512) { const f32x4 v = s[i]; d[i] = (u32x2){pg8::cvt_pk_bf16(v.x, v.y), pg8::cvt_pk_bf16(v.z, v.w)}; } }
        for (int i = bid * 512 + tid; i < S_ * 64; i += G * 512) {
            const int pos_ = i >> 6, d = i & 63; const double rr = 0.86596432336006535; double inv = 1.0; for (int k = 0; k < d; ++k) inv *= rr;
            const double ang = (double)pos_ * inv; const double twopi = 6.283185307179586476925; const double x = ang - twopi * __builtin_rint(ang / twopi);
            double s, c; sincos_small(x * 0.25, s, c); const double s2 = 2.0 * s * c, c2 = c * c - s * s; cosT[i] = (float)(c2 * c2 - s2 * s2); sinT[i] = (float)(2.0 * s2 * c2);
        }
        __syncthreads();
    }
    SEAM(0);

    layer_body<0>(lds, bar, lo, hi, G, vcu);
    layer_body<1>(lds, bar, lo, hi, G, vcu);
#undef IN
#undef SEAM
}
extern "C" void kernel_launch(void* const* d_in, const int* in_sizes, int n_in, void* d_out, int out_size, void* d_ws, size_t ws_size, hipStream_t stream) {
    static int grid = 0;
    if (grid == 0) {
        if (n_in != 21 || ws_size < WS_END || out_size != NTOK * D_) { fprintf(stderr, "kernel_launch: unexpected n_in %d / out_size %d / ws_size %zu (need %zu)\n", n_in, out_size, ws_size, (size_t)WS_END); grid = -1; return; }
        int dev = 0, cus = 0, per_cu = 0;
        if (hipGetDevice(&dev) != hipSuccess || hipDeviceGetAttribute(&cus, hipDeviceAttributeMultiprocessorCount, dev) != hipSuccess) { grid = -1; return; }
        if (hipFuncSetAttribute((const void*)mk_fwd, hipFuncAttributeMaxDynamicSharedMemorySize, LDS_BYTES) != hipSuccess) { fprintf(stderr, "kernel_launch: hipFuncSetAttribute failed\n"); grid = -1; return; }
        if (hipOccupancyMaxActiveBlocksPerMultiprocessor(&per_cu, (const void*)mk_fwd, 512, LDS_BYTES) != hipSuccess || per_cu < 1) { fprintf(stderr, "kernel_launch: occupancy query says %d blocks/CU\n", per_cu); (void)hipGetLastError(); per_cu = 1; }
        grid = cus;
    }
    if (grid < 0) return;
    unsigned char* ws = (unsigned char*)d_ws;
    (void)hipMemsetAsync(ws + WS_CTL, 0, 1 * MiB, stream);
    FArgs fa{};
    for (int i = 0; i < 21; ++i) fa.in[i] = (const float*)d_in[i];
    fa.out = (float*)d_out; fa.ws = ws; fa.pad = 0;
#ifdef PROBE_DUP
    fa.ph_lo = 0; fa.ph_hi = PROBE_DUP + 1; fa.li = 0; hipLaunchKernelGGL(mk_fwd, dim3(grid), dim3(512), LDS_BYTES, stream, fa);
    fa.ph_lo = PROBE_DUP; fa.ph_hi = N_PHASES; fa.li = 1; hipLaunchKernelGGL(mk_fwd, dim3(grid), dim3(512), LDS_BYTES, stream, fa);
    return;
#endif
    fa.ph_lo = 0; fa.ph_hi = N_PHASES; fa.li = 0;
    hipLaunchKernelGGL(mk_fwd, dim3(grid), dim3(512), LDS_BYTES, stream, fa);
}
```

```cpp
#include <hip/hip_runtime.h>
#include <cstdio>
#include <cstdint>

typedef unsigned short bf16;
typedef short bf16x8 __attribute__((ext_vector_type(8)));
typedef float f32x4 __attribute__((ext_vector_type(4)));
typedef float f32x16 __attribute__((ext_vector_type(16)));
typedef unsigned u32x4 __attribute__((ext_vector_type(4)));
typedef unsigned u32x2 __attribute__((ext_vector_type(2)));

constexpr int NB_ = 4, S_ = 2048, D_ = 2048, NTOK = NB_ * S_, DEPTH = 2;
constexpr int NH = 8, HD = 128, RW = 1024, INW = 7168, DFF = 5632, NE = 8, DFFE = 7168, PLED = 256;
constexpr int MOE_P = 18432;
constexpr float ALPHA = 1.4142135623730951f;
constexpr float LN_EPS = 1e-5f;
constexpr float QK_SCALE = 0.08838834764831845f;

constexpr size_t MiB = 1ull << 20;
constexpr size_t WS_CTL   = 0;
constexpr size_t WS_ROT   = 1 * MiB;
constexpr size_t WS_XB    = 2 * MiB;
constexpr size_t WS_PB    = WS_XB + 32 * MiB;
constexpr size_t WS_X1    = WS_PB + 8 * MiB;
constexpr size_t WS_X1B   = WS_X1 + 64 * MiB;
constexpr size_t WS_X2    = WS_X1B + 32 * MiB;
constexpr size_t WS_PLE   = WS_X2 + 64 * MiB;
constexpr size_t WS_PW    = WS_PLE + 64 * MiB;
constexpr size_t WS_Y     = WS_PW + 64 * MiB;
constexpr size_t WS_T1    = WS_Y;
constexpr size_t WS_MOE   = WS_Y + 64 * MiB;
constexpr size_t WS_MIX   = WS_MOE + 1 * MiB;
constexpr size_t WS_H5    = WS_MIX;
constexpr size_t WS_VT    = WS_H5 + 80 * MiB;
constexpr size_t WS_GATES = WS_VT + 32 * MiB;
constexpr size_t WS_O     = WS_GATES + 64 * MiB;
constexpr size_t WS_MERGED= WS_O + 32 * MiB;
constexpr size_t WS_HMID  = WS_MIX;
constexpr size_t WS_XS    = WS_MIX + 252 * MiB;
constexpr size_t WS_YE    = WS_XS + 72 * MiB;
constexpr size_t WS_ACT_END = WS_YE + 72 * MiB;
static_assert(WS_MERGED + 32 * MiB <= WS_XS, "mixer buffers inside the HMID overlay region");
constexpr size_t MO_TOPE = 0, MO_TOPG = 65536, MO_POS = 131072, MO_ROWTOK = 196608, MO_ROWGATE = 294912, MO_BLKE = 393216, MO_META = 397312;

#define DI __device__ __forceinline__
#define LAS __attribute__((address_space(3)))
DI unsigned f2bf(float f) { unsigned u = __builtin_bit_cast(unsigned, f); return (u + 0x7fffu + ((u >> 16) & 1u)) >> 16; }
DI float bf2f(bf16 b) { return __builtin_bit_cast(float, ((unsigned)b) << 16); }
DI float wave_sum(float v) {
#pragma unroll
    for (int o = 1; o < 64; o <<= 1) v += __shfl_xor(v, o);
    return v;
}

DI void sincos_small(double r, double& s, double& c) {
    const double r2 = r * r;
    s = r * (1.0 + r2 * (-1.0 / 6 + r2 * (1.0 / 120 + r2 * (-1.0 / 5040 + r2 * (1.0 / 362880 + r2 * (-1.0 / 39916800 + r2 * (1.0 / 6227020800.0 + r2 * (-1.0 / 1307674368000.0))))))));
    c = 1.0 + r2 * (-0.5 + r2 * (1.0 / 24 + r2 * (-1.0 / 720 + r2 * (1.0 / 40320 + r2 * (-1.0 / 3628800 + r2 * (1.0 / 479001600.0 + r2 * (-1.0 / 87178291200.0 + r2 * (1.0 / 20922789888000.0))))))));
}
DI void bf8_to_f32(const u32x4 w, f32x4& lo, f32x4& hi) {
    lo[0] = __builtin_bit_cast(float, w.x << 16); lo[1] = __builtin_bit_cast(float, w.x & 0xffff0000u); lo[2] = __builtin_bit_cast(float, w.y << 16); lo[3] = __builtin_bit_cast(float, w.y & 0xffff0000u);
    hi[0] = __builtin_bit_cast(float, w.z << 16); hi[1] = __builtin_bit_cast(float, w.z & 0xffff0000u); hi[2] = __builtin_bit_cast(float, w.w << 16); hi[3] = __builtin_bit_cast(float, w.w & 0xffff0000u);
}
template <bool ROUTE, bool COMBINE>
DI void ln_row(int row, int lane, const bf16* __restrict__ Yb, const float* __restrict__ g, const float* __restrict__ bta, float* __restrict__ X, bf16* __restrict__ XB, unsigned char* __restrict__ XB8,
               const LAS float* wT, int* __restrict__ tope, float* __restrict__ topg,
               const bf16* __restrict__ X1B, const bf16* __restrict__ YE, const int* __restrict__ pos, const bf16* __restrict__ PLEB, const u32x4* pre = nullptr) {
    f32x4 v[8]; float s = 0.f;
    if (!COMBINE) {
        if (pre) {
#pragma unroll
            for (int j = 0; j < 4; ++j) bf8_to_f32(pre[j], v[2 * j], v[2 * j + 1]);
        } else {
            const bf16* yr = Yb + (size_t)row * D_ + 8 * lane;
#pragma unroll
            for (int j = 0; j < 4; ++j) bf8_to_f32(*(const u32x4*)(yr + 512 * j), v[2 * j], v[2 * j + 1]);
        }
    } else {
        const int p0 = pos[row * 2], p1 = pos[row * 2 + 1]; const float g0 = topg[row * 2], g1 = topg[row * 2 + 1];
#pragma unroll
        for (int j = 0; j < 4; ++j) { const int c = 8 * lane + 512 * j;
            f32x4 xa, xb, pa, pb, a0, a1, c0, c1;
            bf8_to_f32(*(const u32x4*)(X1B + (size_t)row * D_ + c), xa, xb); bf8_to_f32(*(const u32x4*)(PLEB + (size_t)row * D_ + c), pa, pb);
            bf8_to_f32(*(const u32x4*)(YE + (size_t)p0 * D_ + c), a0, a1);
            bf8_to_f32(*(const u32x4*)(YE + (size_t)p1 * D_ + c), c0, c1);
            v[2 * j] = (ALPHA * xa + (g0 * a0 + g1 * c0)) + pa; v[2 * j + 1] = (ALPHA * xb + (g0 * a1 + g1 * c1)) + pb; }
    }
#pragma unroll
    for (int j = 0; j < 8; ++j) s += (v[j].x + v[j].y) + (v[j].z + v[j].w);
    const float mean = wave_sum(s) * (1.0f / D_); float s2 = 0.f;
#pragma unroll
    for (int j = 0; j < 8; ++j) { v[j] = v[j] - mean; s2 += (v[j].x * v[j].x + v[j].y * v[j].y) + (v[j].z * v[j].z + v[j].w * v[j].w); }
    const float rstd = 1.0f / sqrtf(wave_sum(s2) * (1.0f / D_) + LN_EPS);
    float lg0 = 0.f, lg1 = 0.f, lg2 = 0.f, lg3 = 0.f, lg4 = 0.f, lg5 = 0.f, lg6 = 0.f, lg7 = 0.f;
#pragma unroll
    for (int j = 0; j < 4; ++j) {
        const int c = 8 * lane + 512 * j;
        const f32x4 oa = v[2 * j] * rstd * *(const f32x4*)(g + c) + *(const f32x4*)(bta + c), ob = v[2 * j + 1] * rstd * *(const f32x4*)(g + c + 4) + *(const f32x4*)(bta + c + 4);
        if (X) { *(f32x4*)(X + (size_t)row * D_ + c) = oa; *(f32x4*)(X + (size_t)row * D_ + c + 4) = ob; }
        if (XB) { u32x4 w; w.x = f2bf(oa.x) | (f2bf(oa.y) << 16); w.y = f2bf(oa.z) | (f2bf(oa.w) << 16); w.z = f2bf(ob.x) | (f2bf(ob.y) << 16); w.w = f2bf(ob.z) | (f2bf(ob.w) << 16);
            *(u32x4*)(XB + (size_t)row * D_ + c) = w; }
        if (XB8) { const f32x4 sa = oa * 16.f, sb = ob * 16.f;
            int w0 = __builtin_amdgcn_cvt_pk_fp8_f32(__builtin_amdgcn_fmed3f(sa.x, -448.f, 448.f), __builtin_amdgcn_fmed3f(sa.y, -448.f, 448.f), 0, false);
            w0 = __builtin_amdgcn_cvt_pk_fp8_f32(__builtin_amdgcn_fmed3f(sa.z, -448.f, 448.f), __builtin_amdgcn_fmed3f(sa.w, -448.f, 448.f), w0, true);
            int w1 = __builtin_amdgcn_cvt_pk_fp8_f32(__builtin_amdgcn_fmed3f(sb.x, -448.f, 448.f), __builtin_amdgcn_fmed3f(sb.y, -448.f, 448.f), 0, false);
            w1 = __builtin_amdgcn_cvt_pk_fp8_f32(__builtin_amdgcn_fmed3f(sb.z, -448.f, 448.f), __builtin_amdgcn_fmed3f(sb.w, -448.f, 448.f), w1, true);
            *(u32x2*)(XB8 + (size_t)row * D_ + c) = (u32x2){(unsigned)w0, (unsigned)w1}; }
        if (ROUTE) { v[2 * j] = oa; v[2 * j + 1] = ob; }
    }
    if (ROUTE) {
#pragma unroll 1
        for (int j = 0; j < 8; ++j) {
            const f32x4 o = v[0]; const LAS float* wp = wT + (j & 1) * 1024 + ((j >> 1) * 64 + lane) * 4;
            const f32x4 w0 = *(const LAS f32x4*)(wp), w1 = *(const LAS f32x4*)(wp + 2048), w2 = *(const LAS f32x4*)(wp + 2 * 2048), w3 = *(const LAS f32x4*)(wp + 3 * 2048);
            const f32x4 w4 = *(const LAS f32x4*)(wp + 4 * 2048), w5 = *(const LAS f32x4*)(wp + 5 * 2048), w6 = *(const LAS f32x4*)(wp + 6 * 2048), w7 = *(const LAS f32x4*)(wp + 7 * 2048);
            lg0 += (o[0] * w0[0] + o[1] * w0[1]) + (o[2] * w0[2] + o[3] * w0[3]); lg1 += (o[0] * w1[0] + o[1] * w1[1]) + (o[2] * w1[2] + o[3] * w1[3]);
            lg2 += (o[0] * w2[0] + o[1] * w2[1]) + (o[2] * w2[2] + o[3] * w2[3]); lg3 += (o[0] * w3[0] + o[1] * w3[1]) + (o[2] * w3[2] + o[3] * w3[3]);
            lg4 += (o[0] * w4[0] + o[1] * w4[1]) + (o[2] * w4[2] + o[3] * w4[3]); lg5 += (o[0] * w5[0] + o[1] * w5[1]) + (o[2] * w5[2] + o[3] * w5[3]);
            lg6 += (o[0] * w6[0] + o[1] * w6[1]) + (o[2] * w6[2] + o[3] * w6[3]); lg7 += (o[0] * w7[0] + o[1] * w7[1]) + (o[2] * w7[2] + o[3] * w7[3]);
#pragma unroll
            for (int jj = 0; jj < 7; ++jj) v[jj] = v[jj + 1];
        }
        float lg[8] = {wave_sum(lg0), wave_sum(lg1), wave_sum(lg2), wave_sum(lg3), wave_sum(lg4), wave_sum(lg5), wave_sum(lg6), wave_sum(lg7)};
        if (lane == 0) {
            int i0 = 0; float v0 = lg[0];
#pragma unroll
            for (int e = 1; e < 8; ++e) if (lg[e] > v0) { v0 = lg[e]; i0 = e; }
            int i1 = -1; float v1 = -3.0e38f;
#pragma unroll
            for (int e = 0; e < 8; ++e) if (e != i0 && lg[e] > v1) { v1 = lg[e]; i1 = e; }
            const float e1 = expf(v1 - v0), g0 = 1.0f / (1.0f + e1), g1 = e1 / (1.0f + e1);
            tope[row * 2] = i0; tope[row * 2 + 1] = i1; topg[row * 2] = g0; topg[row * 2 + 1] = g1;
        }
    }
}
#define GAS __attribute__((address_space(1)))

constexpr size_t WS_WIN = WS_ACT_END;
constexpr size_t WS_WBR = WS_WIN + 88 * MiB;
constexpr size_t WS_WO  = WS_WBR + 16 * MiB;
constexpr size_t WS_WP  = WS_WO + 16 * MiB;
constexpr size_t WS_WG  = WS_WP + 2 * MiB;
constexpr size_t WS_WF1 = WS_WG + 16 * MiB;
constexpr size_t WS_WF2 = WS_WF1 + 44 * MiB;
constexpr size_t WS_WM1 = WS_WF2 + 22 * MiB;
constexpr size_t WS_WM2 = WS_WM1 + 448 * MiB;
constexpr size_t WS_RG1 = WS_WM2 + 224 * MiB;
constexpr size_t WS_WG8 = WS_RG1 + 16 * MiB;
constexpr size_t WS_XB8 = WS_WG8 + 16 * MiB;
constexpr size_t WS_END = WS_XB8 + 16 * MiB;
constexpr size_t WS_PBP = WS_X1;
constexpr size_t WS_WPP = WS_X2;

constexpr float W13_SC = 64.f, W2_SC = 128.f, X_SC = 16.f, H_SC = 8.f;
DI int hw_wave_slot() { return (int)(__builtin_amdgcn_s_getreg((5 << 11) | (0 << 6) | 4) & 63u); }
DI int tidx() { const int w = __builtin_amdgcn_readfirstlane(((volatile LAS int*)(131072 + 3072))[hw_wave_slot()]); int ln; asm volatile("v_mbcnt_lo_u32_b32 %0, -1, 0\n\tv_mbcnt_hi_u32_b32 %0, -1, %0" : "=v"(ln)); return (w << 6) + ln; }
namespace pg8 {
constexpr int BM = 256, BK = 64, HALF = 128, HTB = HALF * BK * 2, STAGE_BYTES = 8 * HTB, NXCD = 8, WGM = 8;
__host__ __device__ constexpr __forceinline__ int lds_byte(int r, int c) { const int st = (r >> 4) * 2 + (c >> 5), rr = r & 15, cc = c & 31, ob = rr * 64 + cc * 2; return st * 1024 + (ob ^ (((ob >> 9) & 1) << 5)); }
__host__ __device__ __forceinline__ void stage_rc(int b, int& R, int& C) { const int st = b / 1024, sb = b % 1024, swz = sb ^ (((sb >> 9) & 1) << 5); R = (st >> 1) * 16 + swz / 64; C = (st & 1) * 32 + (swz % 64) / 2; }
__host__ __device__ __forceinline__ int perm32(int rho) { const int n = rho >> 4, i = rho & 15; return 8 * (i >> 2) + 4 * n + (i & 3); }

struct Unit { int pm, pn, aux; };
struct Gemm { const bf16* A; const bf16* Bt; int lda, ldb, K; };

DI bool tile_map(int i, int nM, int nN, int G, int c, int& pm, int& pn) {
    const int nwg = nM * nN; const long L = (long)i * G + c; if (L >= nwg) return false;
    int wgid = (int)L; { const int q = nwg / NXCD, r = nwg % NXCD, xcd = wgid % NXCD, off = wgid / NXCD; wgid = (xcd < r ? xcd * (q + 1) : r * (q + 1) + (xcd - r) * q) + off; }
    const int nig = WGM * nN, gid = wgid / nig, fm = gid * WGM, gsz = (nM - fm) < WGM ? (nM - fm) : WGM;
    pm = fm + ((wgid % nig) % gsz); pn = (wgid % nig) / gsz; return true;
}

typedef __bf16 bf16x2_t __attribute__((ext_vector_type(2)));
typedef float f32x2_t __attribute__((ext_vector_type(2)));
DI unsigned cvt_pk_bf16(float lo, float hi) { const f32x2_t v = {lo, hi}; return __builtin_bit_cast(unsigned, __builtin_convertvector(v, bf16x2_t)); }

typedef int v8i __attribute__((ext_vector_type(8)));
template <class T, class = void> struct sched_vark { static constexpr bool value = false; };
template <class T> struct sched_vark<T, decltype((void)T::VARK)> { static constexpr bool value = T::VARK; };
template <class Epi, class Sched, bool ALIGN_EPI, bool FP8 = false>
DI void gemm_phase(LAS unsigned char* lds, const Gemm g, const Sched& S, const Epi& E) {
    int tid = tidx(); asm volatile("" : "+v"(tid));
    const int wid = __builtin_amdgcn_readfirstlane(tid >> 6), lane = tid & 63, wr = wid >> 2, wc = wid & 3, fr = lane & 15, fq = lane >> 4;
    const int K = g.K; int nt = K / BK;
    unsigned voffA[2], voffB[2];
#pragma unroll
    for (int i = 0; i < 2; ++i) { int R, C; stage_rc(tid * 16 + i * 8192, R, C); const int Rb = Epi::PERM ? ((R & ~31) + perm32(R & 31)) : R;
        voffA[i] = (unsigned)(R * g.lda + C) * 2u; voffB[i] = (unsigned)(Rb * g.ldb + C) * 2u; }
    const size_t kstep = (size_t)(BK * 2);
    const size_t hstepA = (size_t)HALF * g.lda * 2, hstepB = (size_t)HALF * g.ldb * 2;
    const unsigned ldsw = (unsigned)wid * 1024u;
    const unsigned ldsbase = (unsigned)__builtin_amdgcn_readfirstlane((int)(unsigned)(size_t)lds) + ldsw;
    const int aoff = lds_byte(wr * 64 + fr, fq * 8), boff = lds_byte(wc * 32 + fr, fq * 8);
    const int aoff8a = lds_byte(wr * 64 + fr, fq * 16), boff8a = lds_byte(wc * 32 + fr, fq * 16);
    const LAS unsigned char* a8base = lds + aoff8a; const LAS unsigned char* b8base = lds + 4 * HTB + boff8a;
    if constexpr (FP8) { asm volatile("" : "+v"(a8base)); asm volatile("" : "+v"(b8base)); }
    static_assert(lds_byte(9, 24) == lds_byte(9, 16) + 16 && lds_byte(3, 56) == lds_byte(3, 48) + 16, "fp8 fragment pieces are adjacent");
#define PG8_SA(b, h) (((b) * 2 + (h)) * HTB)
#define PG8_SB(b, h) ((4 + (b) * 2 + (h)) * HTB)
#define PG8_STAGE(bufoff, gbase, voff) do { _Pragma("unroll") for (int _i = 0; _i < 2; ++_i) { unsigned keep_; \
        asm volatile("s_mov_b32 %0, m0\n\ts_mov_b32 m0, %3\n\ts_nop 0\n\tglobal_load_lds_dwordx4 %1, %2\n\ts_mov_b32 m0, %0" : "=&s"(keep_) : "v"((voff)[_i]), "s"((const char*)(gbase)), "s"(ldsbase + (unsigned)((bufoff) + _i * 8192)) : "memory"); } } while (0)
#define PG8_LDA(dst, b, h) do { if constexpr (FP8) { _Pragma("unroll") for (int m = 0; m < 4; ++m) { const u32x4 p0_ = *(const LAS u32x4*)(a8base + PG8_SA(b, h) + m * 2048), p1_ = *(const LAS u32x4*)(a8base + PG8_SA(b, h) + m * 2048 + 16); \
            dst##8[m] = (v8i){(int)p0_.x, (int)p0_.y, (int)p0_.z, (int)p0_.w, (int)p1_.x, (int)p1_.y, (int)p1_.z, (int)p1_.w}; } } \
        else { _Pragma("unroll") for (int m = 0; m < 4; ++m) _Pragma("unroll") for (int k = 0; k < 2; ++k) dst[m][k] = *(const LAS bf16x8*)(lds + PG8_SA(b, h) + aoff + m * 2048 + k * 1024); } } while (0)
#define PG8_LDB(dst, b, h) do { if constexpr (FP8) { _Pragma("unroll") for (int n = 0; n < 2; ++n) { const u32x4 p0_ = *(const LAS u32x4*)(b8base + (PG8_SB(b, h) - 4 * HTB) + n * 2048), p1_ = *(const LAS u32x4*)(b8base + (PG8_SB(b, h) - 4 * HTB) + n * 2048 + 16); \
            dst##8[n] = (v8i){(int)p0_.x, (int)p0_.y, (int)p0_.z, (int)p0_.w, (int)p1_.x, (int)p1_.y, (int)p1_.z, (int)p1_.w}; } } \
        else { _Pragma("unroll") for (int n = 0; n < 2; ++n) _Pragma("unroll") for (int k = 0; k < 2; ++k) dst[n][k] = *(const LAS bf16x8*)(lds + PG8_SB(b, h) + boff + n * 2048 + k * 1024); } } while (0)
#define PG8_MMA(ai, bj, At, Bt) do { __builtin_amdgcn_s_setprio(1); \
        if constexpr (FP8) { _Pragma("unroll") for (int m = 0; m < 4; ++m) _Pragma("unroll") for (int n = 0; n < 2; ++n) \
            acc[ai][bj][m][n] = __builtin_amdgcn_mfma_scale_f32_16x16x128_f8f6f4(Bt##8[n], At##8[m], acc[ai][bj][m][n], 0, 0, 0, ((bj) == 0 ? Epi::WSC0 : Epi::WSC1), 0, Epi::ASC); } \
        else { _Pragma("unroll") for (int m = 0; m < 4; ++m) _Pragma("unroll") for (int n = 0; n < 2; ++n) _Pragma("unroll") for (int k = 0; k < 2; ++k) \
            acc[ai][bj][m][n] = __builtin_amdgcn_mfma_f32_16x16x32_bf16(Bt[n][k], At[m][k], acc[ai][bj][m][n], 0, 0, 0); } \
        __builtin_amdgcn_s_setprio(0); } while (0)
#define PG8_WAIT_V(n) asm volatile("s_waitcnt vmcnt(" #n ")" ::: "memory")
#define PG8_WAIT_L(n) asm volatile("s_waitcnt lgkmcnt(" #n ")" ::: "memory")
#define PG8_BAR __builtin_amdgcn_s_barrier()
#define PG8_SCHED __builtin_amdgcn_sched_barrier(0)
    Unit cur, nxt; int ui = 0;
    if (!S.next(0, cur)) return;
    if constexpr (sched_vark<Sched>::value) nt = S.nt(cur);
    f32x4 acc[2][2][4][2];
#pragma unroll
    for (int a = 0; a < 2; ++a)
#pragma unroll
        for (int b = 0; b < 2; ++b)
#pragma unroll
            for (int m = 0; m < 4; ++m)
#pragma unroll
                for (int n = 0; n < 2; ++n) acc[a][b][m][n] = (f32x4){0.f, 0.f, 0.f, 0.f};
    bf16x8 At[4][2], B0[2][2], B1[2][2]; v8i At8[4], B08[2], B18[2];
    const char* cA = (const char*)g.A + S.a_off(cur); const char* cB = (const char*)g.Bt + S.b_off(cur);
    PG8_STAGE(PG8_SB(0, 0), cB, voffB); PG8_STAGE(PG8_SB(0, 1), cB + hstepB, voffB); PG8_STAGE(PG8_SA(0, 0), cA, voffA); PG8_STAGE(PG8_SA(0, 1), cA + hstepA, voffA);
    if (wr == 1) PG8_BAR;
    PG8_WAIT_V(2); PG8_BAR;
    PG8_STAGE(PG8_SB(1, 0), cB + kstep, voffB); PG8_STAGE(PG8_SA(1, 0), cA + kstep, voffA); PG8_STAGE(PG8_SB(1, 1), cB + hstepB + kstep, voffB);
    PG8_WAIT_V(6); PG8_BAR;
    for (;;) {
        const bool has_next = S.next(ui + 1, nxt);
        const char* nA = has_next ? (const char*)g.A + S.a_off(nxt) : cA; const char* nB = has_next ? (const char*)g.Bt + S.b_off(nxt) : cB;
        for (int t = 0; t < nt; t += 2) {
            if constexpr (Epi::MID) { if (t == (nt >> 1)) E.mid(acc, cur, wr, wc, fr, fq); }
            const bool last = (t == nt - 2);
            const char* a1 = cA + (size_t)(t + 1) * kstep;
            const char* a2 = last ? nA : cA + (size_t)(t + 2) * kstep; const char* b2 = last ? nB : cB + (size_t)(t + 2) * kstep;
            const char* a3 = a2 + kstep; const char* b3 = b2 + kstep;
            PG8_LDB(B0, 0, 0); PG8_LDB(B1, 0, 1); PG8_SCHED; PG8_LDA(At, 0, 0); PG8_STAGE(PG8_SA(1, 1), a1 + hstepA, voffA);
            PG8_WAIT_V(8); PG8_WAIT_L(0); PG8_BAR; PG8_MMA(0, 0, At, B0); PG8_MMA(0, 1, At, B1); PG8_BAR; PG8_SCHED;
            PG8_LDA(At, 0, 1); PG8_STAGE(PG8_SB(0, 0), b2, voffB); PG8_STAGE(PG8_SB(0, 1), b2 + hstepB, voffB); PG8_STAGE(PG8_SA(0, 0), a2, voffA);
            PG8_WAIT_V(8); PG8_WAIT_L(0); PG8_BAR; PG8_MMA(1, 0, At, B0); PG8_MMA(1, 1, At, B1); PG8_BAR; PG8_SCHED;
            PG8_LDB(B0, 1, 0); PG8_LDB(B1, 1, 1); PG8_SCHED; PG8_LDA(At, 1, 0); PG8_STAGE(PG8_SA(0, 1), a2 + hstepA, voffA);
            PG8_WAIT_V(8); PG8_WAIT_L(0); PG8_BAR; PG8_MMA(0, 0, At, B0); PG8_MMA(0, 1, At, B1); PG8_BAR; PG8_SCHED;
            PG8_LDA(At, 1, 1); PG8_STAGE(PG8_SB(1, 0), b3, voffB); PG8_STAGE(PG8_SB(1, 1), b3 + hstepB, voffB); PG8_STAGE(PG8_SA(1, 0), a3, voffA);
            PG8_WAIT_V(8); PG8_WAIT_L(0); PG8_BAR; PG8_MMA(1, 0, At, B0); PG8_MMA(1, 1, At, B1); PG8_BAR; PG8_SCHED;
        }
        if constexpr (ALIGN_EPI) { if (wr == 0) PG8_BAR; }
        E(acc, cur, wr, wc, fr, fq);
        if (!has_next) break;
#pragma unroll
        for (int a = 0; a < 2; ++a)
#pragma unroll
            for (int b = 0; b < 2; ++b)
#pragma unroll
                for (int m = 0; m < 4; ++m)
#pragma unroll
                    for (int n = 0; n < 2; ++n) acc[a][b][m][n] = (f32x4){0.f, 0.f, 0.f, 0.f};
        cur = nxt; cA = nA; cB = nB; ++ui;
        if constexpr (sched_vark<Sched>::value) nt = S.nt(cur);
        if constexpr (ALIGN_EPI) { if (wr == 1) PG8_BAR; }
    }
    PG8_WAIT_V(0);
    if constexpr (!ALIGN_EPI) { if (wr == 0) PG8_BAR; }
    PG8_BAR;
#undef PG8_SA
#undef PG8_SB
#undef PG8_STAGE
#undef PG8_LDA
#undef PG8_LDB
#undef PG8_MMA
#undef PG8_WAIT_V
#undef PG8_WAIT_L
#undef PG8_BAR
#undef PG8_SCHED
}

struct SchedPlain {
    int nM, nN, G, c; size_t astep, bstep;
    DI bool next(int i, Unit& u) const { u.aux = 0; return tile_map(i, nM, nN, G, c, u.pm, u.pn); }
    DI size_t a_off(const Unit& u) const { return (size_t)u.pm * astep; }
    DI size_t b_off(const Unit& u) const { return (size_t)u.pn * bstep; }
};
struct SchedA1 {
    int G, c;
    DI bool next(int i, Unit& u) const { int pn; u.aux = 0; if (!tile_map(i, NTOK / 256, 16, G, c, u.pm, pn)) return false; u.pn = pn < 8 ? pn : pn + 8; return true; }
    DI size_t a_off(const Unit& u) const { return (size_t)u.pm * (256 * D_ * 2); }
    DI size_t b_off(const Unit& u) const { return (size_t)u.pn * (256 * D_ * 2); }
};
struct SchedRG {
    int G, c;
    DI bool next(int i, Unit& u) const { int pn2; if (!tile_map(i, NTOK / 256, 8, G, c, u.pm, pn2)) return false; u.pn = pn2 >> 1; u.aux = pn2 & 1; return true; }
    DI size_t a_off(const Unit& u) const { return (size_t)u.pm * (256 * D_ * 2) + (size_t)u.aux * (D_ / 2 * 2); }
    DI size_t b_off(const Unit& u) const { return (size_t)(12 + u.pn) * (256 * D_ * 2) + (size_t)u.aux * (D_ / 2 * 2); }
};
struct SchedVT {
    int G, c;
    DI bool next(int i, Unit& u) const { u.aux = 0; return tile_map(i, 8, NTOK / 256, G, c, u.pm, u.pn); }
    DI size_t a_off(const Unit& u) const { const int phys = u.pm < 4 ? 8 + u.pm : 20 + u.pm; return (size_t)phys * (256 * D_ * 2); }
    DI size_t b_off(const Unit& u) const { return (size_t)u.pn * (256 * D_ * 2); }
};
struct SchedPA {
    static constexpr bool VARK = true;
    int G, c; size_t win, xb, pbp, wpp;
    DI bool next(int i, Unit& u) const {
        const int nA1 = (512 + G - 1) / G, nR = (256 + G - 1) / G;
        const int kind = i < nA1 ? 0 : (i < nA1 + nR ? 1 : (i < nA1 + 2 * nR ? 2 : 3)), ii = kind == 0 ? i : i - nA1 - (kind - 1) * nR;
        int pm = 0, pn = 0; const bool ok = tile_map(ii, kind == 1 ? 8 : NTOK / 256, kind == 0 ? 16 : (kind == 1 ? NTOK / 256 : 8), G, c, pm, pn);
        u.pm = pm; u.pn = kind == 0 ? (pn < 8 ? pn : pn + 8) : (kind == 2 ? pn >> 1 : pn); u.aux = kind == 0 ? 0 : (kind == 1 ? 2 : (kind == 2 ? (4 | (pn & 1)) : 8));
        return ok; }
    DI int nt(const Unit& u) const { return (u.aux & 8) ? PLED / 64 : ((u.aux & 4) ? (D_ / 2) / 64 : D_ / 64); }
    DI size_t a_off(const Unit& u) const {
        if (u.aux & 2) { const int phys = u.pm < 4 ? 8 + u.pm : 20 + u.pm; return win + (size_t)phys * (256 * D_ * 2); }
        if (u.aux & 8) return pbp + (size_t)u.pm * (256 * D_ * 2);
        return xb + (size_t)u.pm * (256 * D_ * 2) + ((u.aux & 4) ? (size_t)(u.aux & 1) * (D_ / 2 * 2) : (size_t)0); }
    DI size_t b_off(const Unit& u) const {
        if (u.aux & 2) return xb + (size_t)u.pn * (256 * D_ * 2);
        if (u.aux & 4) return win + (size_t)(12 + u.pn) * (256 * D_ * 2) + (size_t)(u.aux & 1) * (D_ / 2 * 2);
        if (u.aux & 8) return wpp + (size_t)u.pn * (256 * D_ * 2);
        return win + (size_t)u.pn * (256 * D_ * 2); }
};
struct SchedMerge {
    int G, c;
    DI bool next(int i, Unit& u) const { u.aux = i & 1; return tile_map(i >> 1, NTOK / 256, D_ / 256, G, c, u.pm, u.pn); }
    DI size_t a_off(const Unit& u) const { return (size_t)u.pm * (256 * D_ * 2) + (size_t)u.aux * (RW * 2); }
    DI size_t b_off(const Unit& u) const { return (size_t)u.aux * ((size_t)D_ * RW * 2) + (size_t)u.pn * (256 * RW * 2); }
};
struct SchedMoe {
    const LAS int* blk_e; int nM, nN, G, c; size_t astep, bstep, estep;
    DI bool next(int i, Unit& u) const { if (!tile_map(i, nM, nN, G, c, u.pm, u.pn)) return false; u.aux = __builtin_amdgcn_readfirstlane(blk_e[u.pm]); return true; }
    DI size_t a_off(const Unit& u) const { return (size_t)u.pm * astep; }
    DI size_t b_off(const Unit& u) const { return (size_t)u.aux * estep + (size_t)u.pn * bstep; }
};

struct SchedMoe2 {
    const LAS int* blk_e; int nM, G, c;
    DI bool next(int i, Unit& u) const { int pn2; if (!tile_map(i, nM, 2 * (D_ / 256), G, c, u.pm, pn2)) return false; u.pn = pn2 >> 1; u.aux = __builtin_amdgcn_readfirstlane(blk_e[u.pm]) | ((pn2 & 1) << 8); return true; }
    DI size_t a_off(const Unit& u) const { return (size_t)u.pm * ((size_t)256 * DFFE) + (size_t)(u.aux >> 8) * (DFFE / 2); }
    DI size_t b_off(const Unit& u) const { return (size_t)(u.aux & 255) * ((size_t)D_ * DFFE) + (size_t)u.pn * ((size_t)256 * DFFE) + (size_t)(u.aux >> 8) * (DFFE / 2); }
};
struct SchedTail {
    int nM, nN, G, c, r0; size_t astep, bstep;
    DI bool next(int i, Unit& u) const { u.aux = 0; const int nB = G - r0; if (c < r0) return false; return tile_map(i, nM, nN, nB, c - r0, u.pm, u.pn); }
    DI size_t a_off(const Unit& u) const { return (size_t)u.pm * astep; }
    DI size_t b_off(const Unit& u) const { return (size_t)u.pn * bstep; }
};

DI float sat8(float x) { return __builtin_amdgcn_fmed3f(x, -448.f, 448.f); }
DI unsigned pk4_fp8(float a, float b, float c, float d) { int w = __builtin_amdgcn_cvt_pk_fp8_f32(sat8(a), sat8(b), 0, false); w = __builtin_amdgcn_cvt_pk_fp8_f32(sat8(c), sat8(d), w, true); return (unsigned)w; }
DI float sig_(float x) { return __builtin_amdgcn_rcpf(1.0f + __builtin_amdgcn_exp2f(-1.4426950408889634f * x)); }
#define EPI_ROWS(u, wr, fr) const int row0 = (u).pm * BM + (wr) * 64 + (fr)
struct EpiA1 {
    static constexpr bool PERM = true, MID = false;
    bf16* H5; bf16* G; const float* bias; const float* cosT; const float* sinT;
    DI void operator()(const f32x4 (&acc)[2][2][4][2], const Unit& u, int wr, int wc, int fr, int fq) const {
        EPI_ROWS(u, wr, fr); const int t = u.pn;
        if (t < 8) {
            const float sc = (t < 4) ? QK_SCALE : 1.0f;
            bf16* base = H5 + (size_t)(t >> 2) * NTOK * 1024 + (t & 3) * 256 + wc * 16 + 4 * fq;
#pragma unroll
            for (int ai = 0; ai < 2; ++ai)
#pragma unroll
                for (int m = 0; m < 4; ++m) { const int row = row0 + ai * HALF + m * 16; const int pos = row & (S_ - 1);
                    const f32x4 c = *(const f32x4*)(cosT + pos * 64 + wc * 16 + 4 * fq) * sc, s = *(const f32x4*)(sinT + pos * 64 + wc * 16 + 4 * fq) * sc;
                    bf16* rowp = base + (size_t)row * 1024;
#pragma unroll
                    for (int bj = 0; bj < 2; ++bj) { const f32x4 x1 = acc[ai][bj][m][0], x2 = acc[ai][bj][m][1];
                        const f32x4 o1 = x1 * c - x2 * s, o2 = x1 * s + x2 * c;
                        *(u32x2*)(rowp + bj * HALF) = (u32x2){cvt_pk_bf16(o1[0], o1[1]), cvt_pk_bf16(o1[2], o1[3])};
                        *(u32x2*)(rowp + bj * HALF + 64) = (u32x2){cvt_pk_bf16(o2[0], o2[1]), cvt_pk_bf16(o2[2], o2[3])}; } }
        } else if (t < 28) {
            const int slot = t < 8 ? (t >> 2) : (t >> 2) - 1;
            bf16* base = H5 + (size_t)slot * NTOK * 1024 + (t & 3) * 256 + wc * 32 + 8 * fq;
#pragma unroll
            for (int ai = 0; ai < 2; ++ai)
#pragma unroll
                for (int m = 0; m < 4; ++m) { bf16* rowp = base + (size_t)(row0 + ai * HALF + m * 16) * 1024;
#pragma unroll
                    for (int bj = 0; bj < 2; ++bj) { const f32x4 v0 = acc[ai][bj][m][0], v1 = acc[ai][bj][m][1];
                        u32x4 w; w.x = cvt_pk_bf16(v0[0], v0[1]); w.y = cvt_pk_bf16(v0[2], v0[3]); w.z = cvt_pk_bf16(v1[0], v1[1]); w.w = cvt_pk_bf16(v1[2], v1[3]);
                        *(u32x4*)(rowp + bj * HALF) = w; } }
        } else {
            const int col0 = (t - 28) * 256 + wc * 32 + 8 * fq;
            f32x4 bv[2][2];
#pragma unroll
            for (int bj = 0; bj < 2; ++bj)
#pragma unroll
                for (int n = 0; n < 2; ++n) bv[bj][n] = *(const f32x4*)(bias + col0 + bj * HALF + 4 * n);
#pragma unroll
            for (int ai = 0; ai < 2; ++ai)
#pragma unroll
                for (int m = 0; m < 4; ++m) { bf16* rowp = G + (size_t)(row0 + ai * HALF + m * 16) * 4096 + col0;
#pragma unroll
                    for (int bj = 0; bj < 2; ++bj) { const f32x4 v0 = acc[ai][bj][m][0] + bv[bj][0], v1 = acc[ai][bj][m][1] + bv[bj][1];
                        u32x4 w; w.x = cvt_pk_bf16(sig_(v0[0]), sig_(v0[1])); w.y = cvt_pk_bf16(sig_(v0[2]), sig_(v0[3])); w.z = cvt_pk_bf16(sig_(v1[0]), sig_(v1[1])); w.w = cvt_pk_bf16(sig_(v1[2]), sig_(v1[3]));
                        *(u32x4*)(rowp + bj * HALF) = w; } }
        }
    }
};
struct EpiBf16 {
    static constexpr bool PERM = true, MID = false;
    bf16* O; int ldc;
    DI void operator()(const f32x4 (&acc)[2][2][4][2], const Unit& u, int wr, int wc, int fr, int fq) const {
        EPI_ROWS(u, wr, fr); bf16* base = O + u.pn * BM + wc * 32 + 8 * fq;
#pragma unroll
        for (int ai = 0; ai < 2; ++ai)
#pragma unroll
            for (int m = 0; m < 4; ++m) { bf16* rowp = base + (size_t)(row0 + ai * HALF + m * 16) * ldc;
#pragma unroll
                for (int bj = 0; bj < 2; ++bj) { const f32x4 v0 = acc[ai][bj][m][0], v1 = acc[ai][bj][m][1];
                    u32x4 w; w.x = cvt_pk_bf16(v0[0], v0[1]); w.y = cvt_pk_bf16(v0[2], v0[3]); w.z = cvt_pk_bf16(v1[0], v1[1]); w.w = cvt_pk_bf16(v1[2], v1[3]);
                    *(u32x4*)(rowp + bj * HALF) = w; } }
    }
};
struct EpiRG {
    static constexpr bool PERM = true, MID = false;
    bf16* R0; bf16* R1;
    DI void operator()(const f32x4 (&acc)[2][2][4][2], const Unit& u, int wr, int wc, int fr, int fq) const {
        EPI_ROWS(u, wr, fr); bf16* base = ((u.aux & 1) ? R1 : R0) + u.pn * BM + wc * 32 + 8 * fq;
#pragma unroll
        for (int ai = 0; ai < 2; ++ai)
#pragma unroll
            for (int m = 0; m < 4; ++m) { bf16* rowp = base + (size_t)(row0 + ai * HALF + m * 16) * 1024;
#pragma unroll
                for (int bj = 0; bj < 2; ++bj) { const f32x4 v0 = acc[ai][bj][m][0], v1 = acc[ai][bj][m][1];
                    u32x4 w; w.x = cvt_pk_bf16(v0[0], v0[1]); w.y = cvt_pk_bf16(v0[2], v0[3]); w.z = cvt_pk_bf16(v1[0], v1[1]); w.w = cvt_pk_bf16(v1[2], v1[3]);
                    *(u32x4*)(rowp + bj * HALF) = w; } }
    }
};
struct EpiPA {
    static constexpr bool PERM = true, MID = false;
    bf16* H5; const float* cosT; const float* sinT; bf16* VTp; bf16* RG0; long rgd; bf16* PWp;
    DI void operator()(const f32x4 (&acc)[2][2][4][2], const Unit& u, int wr, int wc, int fr, int fq) const {
        if (u.aux & 2) { const EpiBf16 e{VTp, NTOK}; e(acc, u, wr, wc, fr, fq); }
        else if (u.aux & 8) { const EpiBf16 e{PWp, D_}; e(acc, u, wr, wc, fr, fq); }
        else if (u.aux & 4) { const EpiBf16 e{RG0 + (long)(u.aux & 1) * rgd, 1024}; e(acc, u, wr, wc, fr, fq); }
        else { const EpiA1 e{H5, (bf16*)nullptr, (const float*)nullptr, cosT, sinT}; e(acc, u, wr, wc, fr, fq); }
    }
};
struct EpiSwi8 {
    static constexpr bool PERM = true, MID = false;
    static constexpr int ASC = 122 * 0x01010101, WSC0 = ASC, WSC1 = 125 * 0x01010101;
    static_assert(W13_SC * X_SC == 1024.f && H_SC == 8.f, "block scales above");
    unsigned char* Hm; int ld;
    DI void operator()(const f32x4 (&acc)[2][2][4][2], const Unit& u, int wr, int wc, int fr, int fq) const {
        int row0 = u.pm * BM + wr * 64 + fr; asm volatile("" : "+v"(row0));
        int coff = wc * 32 + 8 * fq; asm volatile("" : "+v"(coff));
        unsigned char* base = Hm + u.pn * HALF + coff;
#pragma unroll
        for (int ai = 0; ai < 2; ++ai)
#pragma unroll
            for (int m = 0; m < 4; ++m) { unsigned char* rowp = base + (size_t)(row0 + ai * HALF + m * 16) * ld;
                float o[8];
#pragma unroll
                for (int n = 0; n < 2; ++n)
#pragma unroll
                    for (int e = 0; e < 4; ++e) { const float a = acc[ai][0][m][n][e], b = acc[ai][1][m][n][e]; o[n * 4 + e] = a * sig_(a) * b; }
                *(u32x2*)rowp = (u32x2){pk4_fp8(o[0], o[1], o[2], o[3]), pk4_fp8(o[4], o[5], o[6], o[7])}; }
    }
};
struct EpiSwiB8 {
    static constexpr bool PERM = true, MID = false;
    unsigned char* Hm; int ld;
    DI void operator()(const f32x4 (&acc)[2][2][4][2], const Unit& u, int wr, int wc, int fr, int fq) const {
        int row0 = u.pm * BM + wr * 64 + fr; asm volatile("" : "+v"(row0));
        int coff = wc * 32 + 8 * fq; asm volatile("" : "+v"(coff));
        unsigned char* base = Hm + u.pn * HALF + coff;
#pragma unroll
        for (int ai = 0; ai < 2; ++ai)
#pragma unroll
            for (int m = 0; m < 4; ++m) { unsigned char* rowp = base + (size_t)(row0 + ai * HALF + m * 16) * ld;
                float o[8];
#pragma unroll
                for (int n = 0; n < 2; ++n)
#pragma unroll
                    for (int e = 0; e < 4; ++e) { const float a = acc[ai][0][m][n][e], b = acc[ai][1][m][n][e]; o[n * 4 + e] = a * sig_(a) * (b * H_SC); }
                *(u32x2*)rowp = (u32x2){pk4_fp8(o[0], o[1], o[2], o[3]), pk4_fp8(o[4], o[5], o[6], o[7])}; }
    }
};
struct EpiGate8 {
    static constexpr bool PERM = true, MID = false;
    static constexpr int ASC = 122 * 0x01010101, WSC0 = ASC, WSC1 = ASC;
    bf16* G; const float* bias;
    DI void operator()(const f32x4 (&acc)[2][2][4][2], const Unit& u, int wr, int wc, int fr, int fq) const {
        int row0 = u.pm * BM + wr * 64 + fr; asm volatile("" : "+v"(row0));
        const int col0 = u.pn * BM + wc * 32 + 8 * fq;
        f32x4 bv[2][2];
#pragma unroll
        for (int bj = 0; bj < 2; ++bj)
#pragma unroll
            for (int n = 0; n < 2; ++n) bv[bj][n] = *(const f32x4*)(bias + col0 + bj * HALF + 4 * n);
#pragma unroll
        for (int ai = 0; ai < 2; ++ai)
#pragma unroll
            for (int m = 0; m < 4; ++m) { bf16* rowp = G + (size_t)(row0 + ai * HALF + m * 16) * 4096 + col0;
#pragma unroll
                for (int bj = 0; bj < 2; ++bj) { const f32x4 v0 = acc[ai][bj][m][0] + bv[bj][0], v1 = acc[ai][bj][m][1] + bv[bj][1];
                    u32x4 w; w.x = cvt_pk_bf16(sig_(v0[0]), sig_(v0[1])); w.y = cvt_pk_bf16(sig_(v0[2]), sig_(v0[3])); w.z = cvt_pk_bf16(sig_(v1[0]), sig_(v1[1])); w.w = cvt_pk_bf16(sig_(v1[2]), sig_(v1[3]));
                    *(u32x4*)(rowp + bj * HALF) = w; } }
    }
};
struct EpiYE2 {
    static constexpr bool PERM = true, MID = false;
    static constexpr int ASC = 122 * 0x01010101, WSC0 = ASC, WSC1 = ASC;
    static_assert(W2_SC * H_SC == 1024.f, "block scale above");
    bf16* O;
    DI void operator()(const f32x4 (&acc)[2][2][4][2], const Unit& u, int wr, int wc, int fr, int fq) const {
        int row0 = u.pm * BM + wr * 64 + fr; asm volatile("" : "+v"(row0));
        int coff = wc * 32 + 8 * fq; asm volatile("" : "+v"(coff));
        bf16* base = O + (size_t)(u.aux >> 8) * ((size_t)MOE_P * D_) + u.pn * BM + coff;
#pragma unroll
        for (int ai = 0; ai < 2; ++ai)
#pragma unroll
            for (int m = 0; m < 4; ++m) { bf16* rowp = base + (size_t)(row0 + ai * HALF + m * 16) * D_;
#pragma unroll
                for (int bj = 0; bj < 2; ++bj) { const f32x4 v0 = acc[ai][bj][m][0], v1 = acc[ai][bj][m][1];
                    u32x4 w; w.x = cvt_pk_bf16(v0[0], v0[1]); w.y = cvt_pk_bf16(v0[2], v0[3]); w.z = cvt_pk_bf16(v1[0], v1[1]); w.w = cvt_pk_bf16(v1[2], v1[3]);
                    *(u32x4*)(rowp + bj * HALF) = w; } }
    }
};
struct EpiSwi {
    static constexpr bool PERM = true, MID = false;
    bf16* Hm; int ld;
    DI void operator()(const f32x4 (&acc)[2][2][4][2], const Unit& u, int wr, int wc, int fr, int fq) const {
        EPI_ROWS(u, wr, fr); bf16* base = Hm + u.pn * HALF + wc * 32 + 8 * fq;
#pragma unroll
        for (int ai = 0; ai < 2; ++ai)
#pragma unroll
            for (int m = 0; m < 4; ++m) { bf16* rowp = base + (size_t)(row0 + ai * HALF + m * 16) * ld;
                float o[8];
#pragma unroll
                for (int n = 0; n < 2; ++n)
#pragma unroll
                    for (int e = 0; e < 4; ++e) { const float a = acc[ai][0][m][n][e], b = acc[ai][1][m][n][e]; o[n * 4 + e] = a * sig_(a) * b; }
                u32x4 w; w.x = cvt_pk_bf16(o[0], o[1]); w.y = cvt_pk_bf16(o[2], o[3]); w.z = cvt_pk_bf16(o[4], o[5]); w.w = cvt_pk_bf16(o[6], o[7]);
                *(u32x4*)rowp = w; }
    }
};
DI void unpack8f(const u32x4 w, f32x4& lo, f32x4& hi) {
    lo[0] = __builtin_bit_cast(float, w.x << 16); lo[1] = __builtin_bit_cast(float, w.x & 0xffff0000u); lo[2] = __builtin_bit_cast(float, w.y << 16); lo[3] = __builtin_bit_cast(float, w.y & 0xffff0000u);
    hi[0] = __builtin_bit_cast(float, w.z << 16); hi[1] = __builtin_bit_cast(float, w.z & 0xffff0000u); hi[2] = __builtin_bit_cast(float, w.w << 16); hi[3] = __builtin_bit_cast(float, w.w & 0xffff0000u);
}
struct EpiMerge {
    static constexpr bool PERM = true, MID = true;
    static constexpr int MIDB = 2;
    const bf16* G; bf16* Mg;
    DI void mid(f32x4 (&acc)[2][2][4][2], const Unit& u, int wr, int wc, int fr, int fq) const {
        int row0 = u.pm * BM + wr * 64 + fr; asm volatile("" : "+v"(row0));
        const int col0 = u.pn * BM + wc * 32 + 8 * fq;
#pragma unroll
        for (int ai = 0; ai < 2; ++ai)
#pragma unroll
            for (int mp = 0; mp < MIDB; ++mp) {
                u32x4 gr[4 / MIDB][2], gs[4 / MIDB][2];
#pragma unroll
                for (int mm = 0; mm < 4 / MIDB; ++mm) { const bf16* gp = G + (size_t)(row0 + ai * HALF + (mp * (4 / MIDB) + mm) * 16) * 4096 + col0;
#pragma unroll
                    for (int bj = 0; bj < 2; ++bj) { gr[mm][bj] = *(const u32x4*)(gp + bj * HALF); gs[mm][bj] = *(const u32x4*)(gp + 2048 + bj * HALF); } }
#pragma unroll
                for (int mm = 0; mm < 4 / MIDB; ++mm) { const int m = mp * (4 / MIDB) + mm;
#pragma unroll
                    for (int bj = 0; bj < 2; ++bj) { f32x4 r0, r1, s0, s1; unpack8f(gr[mm][bj], r0, r1); unpack8f(gs[mm][bj], s0, s1);
#pragma unroll
                        for (int e = 0; e < 4; ++e) { acc[ai][bj][m][0][e] *= r0[e] * __builtin_amdgcn_rcpf(__builtin_fmaxf(s0[e], 1e-30f)); acc[ai][bj][m][1][e] *= r1[e] * __builtin_amdgcn_rcpf(__builtin_fmaxf(s1[e], 1e-30f)); }
                        asm volatile("" : "+v"(acc[ai][bj][m][0]), "+v"(acc[ai][bj][m][1])); } }
                asm volatile("" ::: "memory"); }
    }
    DI void operator()(const f32x4 (&acc)[2][2][4][2], const Unit& u, int wr, int wc, int fr, int fq) const {
        int row0 = u.pm * BM + wr * 64 + fr; asm volatile("" : "+v"(row0));
        const int col0 = u.pn * BM + wc * 32 + 8 * fq;
#pragma unroll
        for (int ai = 0; ai < 2; ++ai)
#pragma unroll
            for (int m = 0; m < 4; ++m) { const size_t r = (size_t)(row0 + ai * HALF + m * 16);
#pragma unroll
                for (int bj = 0; bj < 2; ++bj) { const int c = col0 + bj * HALF; f32x4 s0, s1; unpack8f(*(const u32x4*)(G + r * 4096 + 2048 + c), s0, s1);
                    const f32x4 v0 = acc[ai][bj][m][0] * s0, v1 = acc[ai][bj][m][1] * s1;
                    u32x4 w; w.x = cvt_pk_bf16(v0[0], v0[1]); w.y = cvt_pk_bf16(v0[2], v0[3]); w.z = cvt_pk_bf16(v1[0], v1[1]); w.w = cvt_pk_bf16(v1[2], v1[3]);
                    *(u32x4*)(Mg + r * D_ + c) = w; }
                asm volatile("" ::: "memory"); }
    }
};
struct EpiPleB {
    static constexpr bool PERM = true, MID = false;
    const bf16* PWB; bf16* PLEB;
    DI void operator()(const f32x4 (&acc)[2][2][4][2], const Unit& u, int wr, int wc, int fr, int fq) const {
        int row0 = u.pm * BM + wr * 64 + fr; asm volatile("" : "+v"(row0));
        const int col0 = u.pn * BM + wc * 32 + 8 * fq;
#pragma unroll
        for (int ai = 0; ai < 2; ++ai)
#pragma unroll
            for (int m = 0; m < 4; ++m) { const size_t r = (size_t)(row0 + ai * HALF + m * 16);
#pragma unroll
                for (int bj = 0; bj < 2; ++bj) { const size_t o = r * D_ + col0 + bj * HALF; f32x4 p0, p1; unpack8f(*(const u32x4*)(PWB + o), p0, p1);
                    const f32x4 a0 = acc[ai][bj][m][0], a1 = acc[ai][bj][m][1];
                    u32x4 w; w.x = cvt_pk_bf16(sig_(a0[0]) * p0[0], sig_(a0[1]) * p0[1]); w.y = cvt_pk_bf16(sig_(a0[2]) * p0[2], sig_(a0[3]) * p0[3]);
                    w.z = cvt_pk_bf16(sig_(a1[0]) * p1[0], sig_(a1[1]) * p1[1]); w.w = cvt_pk_bf16(sig_(a1[2]) * p1[2], sig_(a1[3]) * p1[3]);
                    *(u32x4*)(PLEB + o) = w; }
                if (m & 1) asm volatile("" ::: "memory"); }
    }
};
struct EpiYb8 {
    static constexpr bool PERM = true, MID = false;
    static constexpr int ASC = 122 * 0x01010101, WSC0 = ASC, WSC1 = ASC;
    const bf16* R0; const bf16* R1; bf16* Yo;
    DI void operator()(const f32x4 (&acc)[2][2][4][2], const Unit& u, int wr, int wc, int fr, int fq) const {
        int row0 = u.pm * BM + wr * 64 + fr; asm volatile("" : "+v"(row0));
        int col0 = u.pn * BM + wc * 32 + 8 * fq; asm volatile("" : "+v"(col0));
#pragma unroll
        for (int ai = 0; ai < 2; ++ai)
#pragma unroll
            for (int m = 0; m < 4; ++m) { const size_t r = (size_t)(row0 + ai * HALF + m * 16);
#pragma unroll
                for (int bj = 0; bj < 2; ++bj) { const size_t o = r * D_ + col0 + bj * HALF; f32x4 x0, x1, q0, q1; unpack8f(*(const u32x4*)(R0 + o), x0, x1); unpack8f(*(const u32x4*)(R1 + o), q0, q1);
                    const f32x4 v0 = (ALPHA * x0 + acc[ai][bj][m][0]) + q0, v1 = (ALPHA * x1 + acc[ai][bj][m][1]) + q1;
                    u32x4 w; w.x = cvt_pk_bf16(v0[0], v0[1]); w.y = cvt_pk_bf16(v0[2], v0[3]); w.z = cvt_pk_bf16(v1[0], v1[1]); w.w = cvt_pk_bf16(v1[2], v1[3]);
                    *(u32x4*)(Yo + o) = w; }
                asm volatile("" ::: "memory"); }
    }
};
template <bool HAS_R1> struct EpiYb {
    static constexpr bool PERM = true, MID = false;
    static constexpr int ASC = 122 * 0x01010101, WSC0 = ASC, WSC1 = ASC;
    static_assert(W2_SC * H_SC == 1024.f, "block scale above");
    const bf16* R0; const bf16* R1; bf16* Yo;
    DI void operator()(const f32x4 (&acc)[2][2][4][2], const Unit& u, int wr, int wc, int fr, int fq) const {
        int row0 = u.pm * BM + wr * 64 + fr; asm volatile("" : "+v"(row0));
        const int col0 = u.pn * BM + wc * 32 + 8 * fq;
#pragma unroll
        for (int ai = 0; ai < 2; ++ai)
#pragma unroll
            for (int m = 0; m < 4; ++m) { const size_t r = (size_t)(row0 + ai * HALF + m * 16);
#pragma unroll
                for (int bj = 0; bj < 2; ++bj) { const size_t o = r * D_ + col0 + bj * HALF; f32x4 x0, x1; unpack8f(*(const u32x4*)(R0 + o), x0, x1);
                    f32x4 v0 = ALPHA * x0 + acc[ai][bj][m][0], v1 = ALPHA * x1 + acc[ai][bj][m][1];
                    if (HAS_R1) { f32x4 q0, q1; unpack8f(*(const u32x4*)(R1 + o), q0, q1); v0 = v0 + q0; v1 = v1 + q1; }
                    u32x4 w; w.x = cvt_pk_bf16(v0[0], v0[1]); w.y = cvt_pk_bf16(v0[2], v0[3]); w.z = cvt_pk_bf16(v1[0], v1[1]); w.w = cvt_pk_bf16(v1[2], v1[3]);
                    *(u32x4*)(Yo + o) = w; }
                if (m & 1) asm volatile("" ::: "memory"); }
    }
};
template <int MODE> struct EpiF32 {
    static constexpr bool PERM = false, MID = false;
    float* C; const float* R0; const float* R1;
    DI void operator()(const f32x4 (&acc)[2][2][4][2], const Unit& u, int wr, int wc, int fr, int fq) const {
        EPI_ROWS(u, wr, fr); const int col0 = u.pn * BM + wc * 32 + 4 * fq;
#pragma unroll
        for (int ai = 0; ai < 2; ++ai)
#pragma unroll
            for (int m = 0; m < 4; ++m) { const size_t off = (size_t)(row0 + ai * HALF + m * 16) * D_ + col0;
#pragma unroll
                for (int bj = 0; bj < 2; ++bj)
#pragma unroll
                    for (int n = 0; n < 2; ++n) { const size_t o = off + bj * HALF + n * 16; f32x4 v = acc[ai][bj][m][n];
                        if (MODE == 1) v = ALPHA * *(const f32x4*)(R0 + o) + v;
                        if (MODE == 2) { const f32x4 p = *(const f32x4*)(R0 + o); v[0] = sig_(v[0]) * p[0]; v[1] = sig_(v[1]) * p[1]; v[2] = sig_(v[2]) * p[2]; v[3] = sig_(v[3]) * p[3]; }
                        if (MODE == 3) v = (ALPHA * *(const f32x4*)(R0 + o) + v) + *(const f32x4*)(R1 + o);
                        *(f32x4*)(C + o) = v; }
                if (m & 1) asm volatile("" ::: "memory"); }
    }
};
}

#define XB_TMO      128
#define XB_XCNT(j)  (256  + 64 * (j))
#define XB_XSUB(j)  (1280 + 64 * (j))
#define XB_XGEN(j)  (2304 + 64 * (j))
#define XB_TOP      3328
#define XB_TOPGEN   3392
#define XCD_BAR_WORDS 3456
#define XB_SPIN_CAP (1u << 18)
__device__ __forceinline__ unsigned xb_ld(unsigned* p)              { return __hip_atomic_load(p, __ATOMIC_RELAXED, __HIP_MEMORY_SCOPE_AGENT); }
__device__ __forceinline__ unsigned xb_add(unsigned* p, unsigned v) { return __hip_atomic_fetch_add(p, v, __ATOMIC_RELAXED, __HIP_MEMORY_SCOPE_AGENT); }
__device__ __forceinline__ unsigned xb_xcc_id() { return (unsigned)__builtin_amdgcn_s_getreg((3 << 11) | 20) & 0xFu; }
#define XB_SPIN(cond, bar) do { unsigned _sp = 0; while (cond) { __builtin_amdgcn_s_sleep(1); \
    if ((++_sp & 255u) == 0u) { if (xb_ld(&(bar)[XB_TMO])) break; if (_sp > XB_SPIN_CAP) { atomicAdd(&(bar)[XB_TMO], 1u); break; } } } } while (0)
struct XcdBarrier { unsigned* bar; unsigned x; volatile LAS unsigned* st; };
__device__ __forceinline__ XcdBarrier xcd_barrier_post(unsigned* bar, volatile LAS unsigned* st) {
    XcdBarrier b; b.bar = bar; b.x = xb_xcc_id(); b.st = st;
    if (tidx() == 0) (void)xb_add(&bar[XB_XCNT(b.x)], 1u);
    return b;
}
__device__ __forceinline__ void xcd_barrier_complete(unsigned* bar, unsigned x, unsigned& nloc, unsigned& nx) {
    const unsigned G = gridDim.x * gridDim.y * gridDim.z;
    unsigned sum, cnt, mine, sp = 0u;
    for (;;) {
        sum = 0u; cnt = 0u; mine = 0u;
#pragma unroll
        for (unsigned j = 0; j < 16; ++j) { const unsigned c = xb_ld(&bar[XB_XCNT(j)]); sum += c; cnt += (c > 0u) ? 1u : 0u; mine = (j == x) ? c : mine; }
        if (sum == G) break;
        __builtin_amdgcn_s_sleep(1);
        if ((++sp & 255u) == 0u) { if (xb_ld(&bar[XB_TMO])) break; if (sp > XB_SPIN_CAP) { atomicAdd(&bar[XB_TMO], 1u); break; } }
    }
    nloc = mine > 0u ? mine : 1u; nx = cnt > 0u ? cnt : 1u;
}
__device__ __forceinline__ void xcd_barrier(const XcdBarrier& b) {
    asm volatile("s_waitcnt vmcnt(0)" ::: "memory");
    __syncthreads();
    if (tidx() == 0) {
        unsigned* bar = b.bar;
        __builtin_amdgcn_s_waitcnt(0);
        unsigned nloc = b.st[0], nx = b.st[1];
        if (nloc == 0u) { xcd_barrier_complete(bar, b.x, nloc, nx); b.st[0] = nloc; b.st[1] = nx; }
        const unsigned old = xb_add(&bar[XB_XSUB(b.x)], 1u);
        const unsigned gen = old / nloc;
        if (old + 1u == (gen + 1u) * nloc) {
            __builtin_amdgcn_fence(__ATOMIC_RELEASE, "agent");
            asm volatile("s_waitcnt vmcnt(0)" ::: "memory");
            const unsigned og = xb_add(&bar[XB_TOP], 1u);
            const unsigned tg = og / nx;
            if (og + 1u == (tg + 1u) * nx) xb_add(&bar[XB_TOPGEN], 1u);
            else XB_SPIN(xb_ld(&bar[XB_TOPGEN]) == tg, bar);
            __builtin_amdgcn_fence(__ATOMIC_ACQUIRE, "agent");
            xb_add(&bar[XB_XGEN(b.x)], 1u);
            asm volatile("s_waitcnt vmcnt(0)" ::: "memory");
        } else {
            XB_SPIN(xb_ld(&bar[XB_XGEN(b.x)]) == gen, bar);
            __builtin_amdgcn_fence(__ATOMIC_ACQUIRE, "agent");
            asm volatile("s_waitcnt vmcnt(0)" ::: "memory");
        }
    }
    __syncthreads();
}

constexpr int RING_BYTES = 131072;
constexpr int LDSCTL_OFF = RING_BYTES, MISC_OFF = LDSCTL_OFF + 320;
constexpr int LDS_BYTES = 147456;
constexpr int CW_BAR = 4096;

#define LDS_WAIT() asm volatile("s_waitcnt lgkmcnt(0)" ::: "memory")

struct CvtSeg { const float* W; bf16* dst; int E, K, N, ncols, mode, dld, kofs; };
DI int rot_slot(int d) { return 32 * ((d & 63) >> 4) + 8 * ((d >> 2) & 3) + 4 * (d >> 6) + (d & 3); }
DI void cvt_decode(const CvtSeg& s, int it, const float*& src, bf16*& d, int& k0, int& nloc0) {
    const int nnb = s.ncols / 64, per = (s.K / 64) * nnb; const int e = it / per, r = it - e * per, kb = r / nnb, nb = r - kb * nnb, n0 = nb * 64; k0 = kb * 64; nloc0 = n0 & 127;
    src = s.W + (size_t)e * s.K * s.N + (size_t)k0 * s.N + n0;
    if (s.mode == 0) d = s.dst + (size_t)e * s.ncols * s.dld + (size_t)n0 * s.dld + s.kofs + k0;
    else if (s.mode == 3) d = s.dst + (size_t)(n0 & ~127) * s.dld + s.kofs + k0;
    else d = s.dst + (size_t)e * 2 * s.ncols * s.dld + (size_t)((n0 >> 7) * 256 + (n0 & 127) + (s.mode == 2 ? 128 : 0)) * s.dld + s.kofs + k0;
}
DI void cvt_load(const CvtSeg& s, int it, f32x4 (&v)[16], int lane) {
    const float* src; bf16* d; int k0, nl0; cvt_decode(s, it, src, d, k0, nl0);
    const int half = lane >> 4, n4 = (lane & 15) * 4; src += (size_t)(2 * half) * s.N + n4;
#pragma unroll
    for (int j = 0; j < 8; ++j) { v[2 * j] = __builtin_nontemporal_load((const f32x4*)(src + (size_t)(8 * j) * s.N)); v[2 * j + 1] = __builtin_nontemporal_load((const f32x4*)(src + (size_t)(8 * j + 1) * s.N)); }
}
DI void cvt_store(const CvtSeg& s, int it, const f32x4 (&v)[16], LAS unsigned* T, int lane) {
    const float* src; bf16* d; int k0, nl0; cvt_decode(s, it, src, d, k0, nl0);
    const int half = lane >> 4, n4 = (lane & 15) * 4;
#pragma unroll
    for (int j = 0; j < 8; ++j)
#pragma unroll
        for (int q = 0; q < 4; ++q) T[(n4 + q) * 33 + 4 * j + half] = pg8::cvt_pk_bf16(v[2 * j][q], v[2 * j + 1][q]);
    LDS_WAIT();
    const int c = lane & 7;
#pragma unroll
    for (int jj = 0; jj < 8; ++jj) { const int n = (lane >> 3) + 8 * jj; const LAS unsigned* t = T + n * 33 + 4 * c;
        u32x4 o; o.x = t[0]; o.y = t[1]; o.z = t[2]; o.w = t[3];
        const int row = (s.mode == 3) ? rot_slot(nl0 + n) : n;
        *(u32x4*)(d + (size_t)row * s.dld + 8 * c) = o; }
    LDS_WAIT();
}
using pg8::pk4_fp8;
DI void cvt8_decode(const CvtSeg& s, int it, const float*& src, unsigned char*& d) {
    const int nnb = s.ncols / 64, per = (s.K / 128) * nnb; const int e = it / per, r = it - e * per, kb = r / nnb, nb = r - kb * nnb, n0 = nb * 64, k0 = kb * 128;
    src = s.W + (size_t)e * s.K * s.N + (size_t)k0 * s.N + n0;
    if (s.mode == 0) d = (unsigned char*)s.dst + (size_t)e * s.ncols * s.dld + (size_t)n0 * s.dld + s.kofs + k0;
    else d = (unsigned char*)s.dst + (size_t)e * 2 * s.ncols * s.dld + (size_t)((n0 >> 7) * 256 + (n0 & 127) + (s.mode == 2 ? 128 : 0)) * s.dld + s.kofs + k0;
}
DI void cvt8_load_half(const CvtSeg& s, int it, int hh, f32x4 (&v)[16], int lane) {
    const float* src; unsigned char* d; cvt8_decode(s, it, src, d);
    src += (size_t)(64 * hh + 4 * (lane >> 4)) * s.N + (lane & 15) * 4;
#pragma unroll
    for (int j = 0; j < 4; ++j)
#pragma unroll
        for (int i = 0; i < 4; ++i) v[4 * j + i] = __builtin_nontemporal_load((const f32x4*)(src + (size_t)(16 * j + i) * s.N));
}
DI void cvt8_pack_half(const f32x4 (&v)[16], int hh, float sc, LAS unsigned* T, int lane) {
    const int kq = lane >> 4, n4 = (lane & 15) * 4;
#pragma unroll
    for (int j = 0; j < 4; ++j)
#pragma unroll
        for (int q = 0; q < 4; ++q) T[(n4 + q) * 33 + 4 * (4 * hh + j) + kq] = pk4_fp8(v[4 * j][q] * sc, v[4 * j + 1][q] * sc, v[4 * j + 2][q] * sc, v[4 * j + 3][q] * sc);
}
DI void cvt8_store(const CvtSeg& s, int it, LAS unsigned* T, int lane) {
    const float* src; unsigned char* d; cvt8_decode(s, it, src, d);
    LDS_WAIT();
    const int c = lane & 7;
#pragma unroll
    for (int jj = 0; jj < 8; ++jj) { const int n = (lane >> 3) + 8 * jj; const LAS unsigned* t = T + n * 33 + 4 * c;
        u32x4 o; o.x = t[0]; o.y = t[1]; o.z = t[2]; o.w = t[3];
        *(u32x4*)(d + (size_t)n * s.dld + 16 * c) = o; }
    LDS_WAIT();
}
DI void cvt_seg8(const CvtSeg& s, float sc, int& rot, int gw, int NGW, LAS unsigned* T, int lane) {
    const int total = s.E * (s.K / 128) * (s.ncols / 64);
    int it = gw - rot; if (it < 0) it += NGW;
    rot = (rot + total) % NGW;
    f32x4 va[16], vb[16];
    if (it < total) cvt8_load_half(s, it, 0, va, lane);
    while (it < total) {
        cvt8_load_half(s, it, 1, vb, lane);
        cvt8_pack_half(va, 0, sc, T, lane);
        const int itn = it + NGW;
        if (itn < total) cvt8_load_half(s, itn, 0, va, lane);
        cvt8_pack_half(vb, 1, sc, T, lane);
        cvt8_store(s, it, T, lane);
        it = itn;
    }
}
DI void cvt_seg(const CvtSeg& s, int& rot, int gw, int NGW, LAS unsigned* T, int lane) {
    const int total = s.E * (s.K / 64) * (s.ncols / 64);
    int it = gw - rot; if (it < 0) it += NGW;
    rot = (rot + total) % NGW;
    f32x4 va[16], vb[16];
    if (it < total) cvt_load(s, it, va, lane);
    while (it < total) {
        int itn = it + NGW;
        if (itn < total) cvt_load(s, itn, vb, lane);
        cvt_store(s, it, va, T, lane);
        it = itn; if (it >= total) break;
        itn = it + NGW;
        if (itn < total) cvt_load(s, itn, va, lane);
        cvt_store(s, it, vb, T, lane);
        it = itn;
    }
}

namespace att {
constexpr int KS_ = 272, VS_ = 136, KBUF = 64 * KS_, VBUF = 128 * VS_;
constexpr int RTS = 272, RT_OFF = 73728;
constexpr float C2 = QK_SCALE * 1.4426950408889634f;
typedef short s16x4 __attribute__((ext_vector_type(4)));
DI void unpack8(const u32x4 w, float (&f)[8]) {
    f[0] = __builtin_bit_cast(float, w.x << 16); f[1] = __builtin_bit_cast(float, w.x & 0xffff0000u); f[2] = __builtin_bit_cast(float, w.y << 16); f[3] = __builtin_bit_cast(float, w.y & 0xffff0000u);
    f[4] = __builtin_bit_cast(float, w.z << 16); f[5] = __builtin_bit_cast(float, w.z & 0xffff0000u); f[6] = __builtin_bit_cast(float, w.w << 16); f[7] = __builtin_bit_cast(float, w.w & 0xffff0000u);
}
DI u32x4 pack8(const float (&f)[8]) { u32x4 w; w.x = pg8::cvt_pk_bf16(f[0], f[1]); w.y = pg8::cvt_pk_bf16(f[2], f[3]); w.z = pg8::cvt_pk_bf16(f[4], f[5]); w.w = pg8::cvt_pk_bf16(f[6], f[7]); return w; }
DI u32x4 scale8(const u32x4 w, float s) { float x[8]; unpack8(w, x);
#pragma unroll
    for (int j = 0; j < 8; ++j) x[j] *= s;
    return pack8(x); }

struct Tile { u32x4 ka, kb, va, vb; };

template <int BR>
DI void unit(LAS unsigned char* lds, const bf16* __restrict__ Q, const bf16* __restrict__ Kx, const bf16* __restrict__ VT, const bf16* __restrict__ RG, const bf16* __restrict__ RG1, bf16* __restrict__ O, int b, int h, int qb) {
    int tid = tidx(); asm volatile("" : "+v"(tid));
    const int lane = tid & 63, wave = __builtin_amdgcn_readfirstlane(tid >> 6);
    const int r32 = lane & 31, hf = lane >> 5;
    const int t0 = qb * 256, tw0 = t0 + 32 * wave, t = tw0 + r32;
    const size_t tok = (size_t)b * S_ + t;
    bf16x8 qf[8];
    { const bf16* qr = Q + tok * 1024 + h * HD + 8 * hf;
#pragma unroll
      for (int ks = 0; ks < 8; ++ks) qf[ks] = *(const bf16x8*)(qr + 16 * ks); }
    const float lg2 = (BR == 0) ? __log2f(1.0f - exp2f(-5.0f - (float)h)) : 0.f;
    const int kkey = tid >> 3, kc = tid & 7, vd = tid >> 2, vc = tid & 3;
    const bf16* kbase = Kx + ((size_t)b * S_ + kkey) * 1024 + h * HD + 8 * kc;
    const bf16* vbase = VT + (size_t)(BR * 1024 + h * HD + vd) * NTOK + (size_t)b * S_ + 16 * vc;
#define ATT_LOAD(T, jt) do { const int s0_ = (jt) * 64; const bf16* kr_ = kbase + (size_t)s0_ * 1024; T.ka = *(const u32x4*)kr_; T.kb = *(const u32x4*)(kr_ + 64); \
        T.va = *(const u32x4*)(vbase + s0_); T.vb = *(const u32x4*)(vbase + s0_ + 8); } while (0)
#define ATT_STORE(T, buf, KA, KB) do { LAS unsigned char* kd_ = lds + (buf) * KBUF + kkey * KS_ + 16 * kc; *(LAS u32x4*)kd_ = (KA); *(LAS u32x4*)(kd_ + 128) = (KB); \
        LAS unsigned char* vp_ = lds + 2 * KBUF + (buf) * VBUF + vd * VS_ + 32 * vc; \
        *(LAS u32x2*)vp_ = (u32x2){T.va.x, T.va.y}; *(LAS u32x2*)(vp_ + 8) = (u32x2){T.va.z, T.va.w}; *(LAS u32x2*)(vp_ + 16) = (u32x2){T.vb.x, T.vb.y}; *(LAS u32x2*)(vp_ + 24) = (u32x2){T.vb.z, T.vb.w}; } while (0)

    f32x16 oT[4];
#pragma unroll
    for (int dt = 0; dt < 4; ++dt)
#pragma unroll
        for (int i = 0; i < 16; ++i) oT[dt][i] = 0.f;
    Tile ta, tb;
    if (BR == 0 && qb > 0) {
        f32x16 Racc[2];
#pragma unroll
        for (int i = 0; i < 16; ++i) { Racc[0][i] = 0.f; Racc[1][i] = 0.f; }
        const int i16 = lane & 15, tq_ = i16 >> 2, tp_ = i16 & 3, tblk = (lane >> 4) & 1;
        const int ka_off = (8 * hf + tq_) * KS_ + 64 * (wave >> 1) + 8 * (4 * tblk + tp_);
        const int vb_off = (64 * (wave & 1) + r32) * VS_ + 16 * hf;
#define P1_STORE(T, buf, jt) do { const float dec_ = __builtin_amdgcn_exp2f((float)(t0 - (jt) * 64 - kkey) * lg2); const u32x4 ka_ = scale8(T.ka, dec_), kb_ = scale8(T.kb, dec_); ATT_STORE(T, buf, ka_, kb_); } while (0)
#define P1_COMPUTE(buf) do { const LAS unsigned char* kimg = lds + (buf) * KBUF + ka_off; const LAS unsigned char* vimg = lds + 2 * KBUF + (buf) * VBUF + vb_off; \
            _Pragma("unroll") for (int ks = 0; ks < 4; ++ks) { \
                const s16x4 alo = __builtin_amdgcn_ds_read_tr16_b64_v4i16((LAS s16x4*)(kimg + 16 * ks * KS_)), ahi = __builtin_amdgcn_ds_read_tr16_b64_v4i16((LAS s16x4*)(kimg + (16 * ks + 4) * KS_)); \
                const bf16x8 a = __builtin_shufflevector(alo, ahi, 0, 1, 2, 3, 4, 5, 6, 7); \
                _Pragma("unroll") for (int tt = 0; tt < 2; ++tt) { const u32x2 lo = *(const LAS u32x2*)(vimg + tt * 32 * VS_ + 32 * ks), hi = *(const LAS u32x2*)(vimg + tt * 32 * VS_ + 32 * ks + 8); \
                    const bf16x8 bb = __builtin_bit_cast(bf16x8, (u32x4){lo.x, lo.y, hi.x, hi.y}); Racc[tt] = __builtin_amdgcn_mfma_f32_32x32x16_bf16(a, bb, Racc[tt], 0, 0, 0); } } } while (0)
        const int np = 4 * qb;
        ATT_LOAD(ta, 0); ATT_LOAD(tb, 1);
        for (int jt = 0; jt < np; jt += 2) {
            P1_STORE(ta, 0, jt);
            __syncthreads();
            if (jt + 2 < np) ATT_LOAD(ta, jt + 2);
            P1_COMPUTE(0);
            P1_STORE(tb, 1, jt + 1);
            __syncthreads();
            if (jt + 3 < np) ATT_LOAD(tb, jt + 3);
            P1_COMPUTE(1);
        }
#undef P1_STORE
#undef P1_COMPUTE
#pragma unroll
        for (int tt = 0; tt < 2; ++tt) { LAS unsigned char* rp = lds + RT_OFF + (32 * (2 * (wave & 1) + tt) + r32) * RTS + (32 * (wave >> 1) + 4 * hf) * 2;
#pragma unroll
            for (int g = 0; g < 4; ++g) *(LAS u32x2*)(rp + 16 * g) = (u32x2){pg8::cvt_pk_bf16(Racc[tt][4 * g], Racc[tt][4 * g + 1]), pg8::cvt_pk_bf16(Racc[tt][4 * g + 2], Racc[tt][4 * g + 3])}; }
        __syncthreads();
        const LAS unsigned char* rb = lds + RT_OFF + r32 * RTS + 16 * hf;
#pragma unroll
        for (int dt = 0; dt < 4; ++dt)
#pragma unroll
            for (int ks = 0; ks < 8; ++ks) { const bf16x8 a = *(const LAS bf16x8*)(rb + dt * 32 * RTS + 32 * ks); oT[dt] = __builtin_amdgcn_mfma_f32_32x32x16_bf16(a, qf[ks], oT[dt], 0, 0, 0); }
        const float sc = __builtin_amdgcn_exp2f((float)(t - t0) * lg2);
#pragma unroll
        for (int dt = 0; dt < 4; ++dt)
#pragma unroll
            for (int i = 0; i < 16; ++i) oT[dt][i] *= sc;
    }
    float carry = 0.f; bool wdone = false;
    LAS int* flg = (LAS int*)(lds + 2 * KBUF + 2 * VBUF);
    const int last = 4 * qb + 3;
    const int jmin = (BR == 0) ? 4 * qb : 0;
    ATT_LOAD(ta, last);
    for (int jt = last, it = 0; jt >= jmin; --jt, ++it) {
        const int buf = it & 1;
        ATT_STORE(ta, buf, ta.ka, ta.kb);
        __syncthreads();
        if (BR == 1 && it > 0) {
            int all = 1;
#pragma unroll
            for (int w8 = 0; w8 < 8; ++w8) all &= flg[((it - 1) & 1) * 8 + w8];
            if (all) break;
        }
        if (jt > jmin) ATT_LOAD(ta, jt - 1);
        const int s0 = jt * 64;
        if (s0 <= tw0 + 31 && !wdone) {
            const int tq = t - s0 - 4 * hf;
            bf16x8 pf[4];
            const LAS unsigned char* kb_ = lds + buf * KBUF + r32 * KS_ + 16 * hf;
#pragma unroll
            for (int kk = 0; kk < 2; ++kk) {
                const int kt = 1 - kk;
                f32x16 sT;
#pragma unroll
                for (int i = 0; i < 16; ++i) sT[i] = 0.f;
#pragma unroll
                for (int ks = 0; ks < 8; ++ks) { const bf16x8 a = *(const LAS bf16x8*)(kb_ + kt * 32 * KS_ + 32 * ks); sT = __builtin_amdgcn_mfma_f32_32x32x16_bf16(a, qf[ks], sT, 0, 0, 0); }
                float w[16];
                if (BR == 1) {
#pragma unroll
                    for (int gg = 0; gg < 4; ++gg) {
                        const int g = 3 - gg;
                        float lf[4], ls[4]; bool vd_[4];
#pragma unroll
                        for (int e = 0; e < 4; ++e) {
                            const float z2 = __builtin_amdgcn_fmed3f(sT[4 * g + e] * C2, -126.f, 126.f);
                            const float ex = __builtin_amdgcn_exp2f(z2); const float sp = __builtin_amdgcn_logf(1.0f + ex);
                            vd_[e] = (32 * kt + 8 * g + e) < tq; lf[e] = vd_[e] ? -sp : 0.f; ls[e] = z2 - sp;
                        }
                        const float s2 = lf[3], s1 = s2 + lf[2], s0x = s1 + lf[1], T = s0x + lf[0];
                        const float Tp = __shfl_xor(T, 32);
                        const float off = carry + (hf == 0 ? Tp : 0.f);
                        w[4 * g + 3] = vd_[3] ? __builtin_amdgcn_exp2f(ls[3] + off) : 0.f;
                        w[4 * g + 2] = vd_[2] ? __builtin_amdgcn_exp2f(ls[2] + (off + s2)) : 0.f;
                        w[4 * g + 1] = vd_[1] ? __builtin_amdgcn_exp2f(ls[1] + (off + s1)) : 0.f;
                        w[4 * g + 0] = vd_[0] ? __builtin_amdgcn_exp2f(ls[0] + (off + s0x)) : 0.f;
                        carry += T + Tp;
                    }
                } else {
                    const float basef = (float)tq * lg2;
#pragma unroll
                    for (int r = 0; r < 16; ++r) { const int c = 32 * kt + 8 * (r >> 2) + (r & 3);
                        const float dec = __builtin_amdgcn_exp2f(basef - (float)c * lg2);
                        w[r] = (c <= tq) ? sT[r] * dec : 0.f; }
                }
                float w0[8], w1[8];
#pragma unroll
                for (int j = 0; j < 8; ++j) { w0[j] = w[j]; w1[j] = w[8 + j]; }
                pf[2 * kt] = __builtin_bit_cast(bf16x8, pack8(w0)); pf[2 * kt + 1] = __builtin_bit_cast(bf16x8, pack8(w1));
            }
            const LAS unsigned char* vb_ = lds + 2 * KBUF + buf * VBUF + r32 * VS_ + 8 * hf;
#pragma unroll
            for (int dt = 0; dt < 4; ++dt)
#pragma unroll
                for (int sp = 0; sp < 4; ++sp) {
                    const u32x2 lo = *(const LAS u32x2*)(vb_ + dt * 32 * VS_ + 32 * sp), hi = *(const LAS u32x2*)(vb_ + dt * 32 * VS_ + 32 * sp + 16);
                    const bf16x8 a = __builtin_bit_cast(bf16x8, (u32x4){lo.x, lo.y, hi.x, hi.y});
                    oT[dt] = __builtin_amdgcn_mfma_f32_32x32x16_bf16(a, pf[sp], oT[dt], 0, 0, 0);
                }
            if (BR == 1) wdone = __all(carry <= -150.0f) != 0;
        }
        if (BR == 1 && lane == 0) flg[(it & 1) * 8 + wave] = wdone ? 1 : 0;
    }
#undef ATT_LOAD
#undef ATT_STORE
    if (BR == 0) {
        float s = 0.f;
#pragma unroll
        for (int dt = 0; dt < 4; ++dt)
#pragma unroll
            for (int i = 0; i < 16; ++i) s += oT[dt][i];
        s += __shfl_xor(s, 32);
        const float mean = s * (1.0f / 128.0f); float q = 0.f;
#pragma unroll
        for (int dt = 0; dt < 4; ++dt)
#pragma unroll
            for (int i = 0; i < 16; ++i) { const float d = oT[dt][i] - mean; q += d * d; }
        q += __shfl_xor(q, 32);
        const float rstd = 1.0f / sqrtf(q * (1.0f / 128.0f) + LN_EPS);
        const bf16* gr = RG + tok * 1024 + h * HD + 4 * hf; const bf16* gr1 = RG1 + tok * 1024 + h * HD + 4 * hf; bf16* orow = O + tok * D_ + h * HD + 4 * hf;
#pragma unroll
        for (int dt = 0; dt < 4; ++dt)
#pragma unroll
            for (int g = 0; g < 4; ++g) { const int d = 32 * dt + 8 * g;
                const u32x2 gw = *(const u32x2*)(gr + d), gx = *(const u32x2*)(gr1 + d);
                const float g0 = __builtin_bit_cast(float, gw.x << 16) + __builtin_bit_cast(float, gx.x << 16), g1 = __builtin_bit_cast(float, gw.x & 0xffff0000u) + __builtin_bit_cast(float, gx.x & 0xffff0000u);
                const float g2 = __builtin_bit_cast(float, gw.y << 16) + __builtin_bit_cast(float, gx.y << 16), g3 = __builtin_bit_cast(float, gw.y & 0xffff0000u) + __builtin_bit_cast(float, gx.y & 0xffff0000u);
                const float o0 = (oT[dt][4 * g] - mean) * rstd * (g0 * pg8::sig_(g0)), o1 = (oT[dt][4 * g + 1] - mean) * rstd * (g1 * pg8::sig_(g1));
                const float o2 = (oT[dt][4 * g + 2] - mean) * rstd * (g2 * pg8::sig_(g2)), o3 = (oT[dt][4 * g + 3] - mean) * rstd * (g3 * pg8::sig_(g3));
                *(u32x2*)(orow + d) = (u32x2){pg8::cvt_pk_bf16(o0, o1), pg8::cvt_pk_bf16(o2, o3)}; }
    } else {
        bf16* orow = O + tok * D_ + 1024 + h * HD + 4 * hf;
#pragma unroll
        for (int dt = 0; dt < 4; ++dt)
#pragma unroll
            for (int g = 0; g < 4; ++g) { const int d = 32 * dt + 8 * g;
                *(u32x2*)(orow + d) = (u32x2){pg8::cvt_pk_bf16(oT[dt][4 * g], oT[dt][4 * g + 1]), pg8::cvt_pk_bf16(oT[dt][4 * g + 2], oT[dt][4 * g + 3])}; }
    }
    __syncthreads();
}
}

constexpr int PH_PER_LAYER = 9, N_PHASES = 1 + DEPTH * PH_PER_LAYER;
struct FArgs { const float* in[21]; float* out; unsigned char* ws; int ph_lo, ph_hi, li, pad; };
typedef const __attribute__((address_space(4))) FArgs* KArgP;
DI KArgP kargs() { KArgP p = (KArgP)__builtin_amdgcn_kernarg_segment_ptr(); asm volatile("" : "+s"(p)); return p; }


#define IN(k) (lo <= (k) && (k) < hi)
#define SEAM(k) do { if (IN(k) && IN((k) + 1)) xcd_barrier(bar); } while (0)
#define PHASE_IDS() int tid = tidx(); asm volatile("" : "+v"(tid)); const int lane = tid & 63, wave = __builtin_amdgcn_readfirstlane(tid >> 6), gw = vcu * 8 + wave; (void)lane; (void)gw
#define cosT ((float*)(ws + WS_ROT))
#define sinT ((float*)(ws + WS_ROT) + S_ * 64)
#define XB ((bf16*)(ws + WS_XB))
#define PB ((bf16*)(ws + WS_PB))
#define H5 ((bf16*)(ws + WS_H5))
#define VT ((bf16*)(ws + WS_VT))
#define GATES ((bf16*)(ws + WS_GATES))
#define O ((bf16*)(ws + WS_O))
#define T1 ((float*)(ws + WS_T1))
#define MERGED ((bf16*)(ws + WS_MERGED))
#define Yb ((bf16*)(ws + WS_Y))
#define X1B ((bf16*)(ws + WS_X1B))
#define PLEB ((bf16*)(ws + WS_PLE))
#define PWB ((bf16*)(ws + WS_PW))
#define HMID ((bf16*)(ws + WS_HMID))
#define XS ((bf16*)(ws + WS_XS))
#define YE2 ((bf16*)(ws + WS_XS))
#define tope ((int*)(ws + WS_MOE + MO_TOPE))
#define topg ((float*)(ws + WS_MOE + MO_TOPG))
#define pos ((int*)(ws + WS_MOE + MO_POS))
#define blk_e ((int*)(ws + WS_MOE + MO_BLKE))
#define meta ((int*)(ws + WS_MOE + MO_META))
template <int l>
DI void layer_body(LAS unsigned char* lds, const XcdBarrier& bar, const int lo, const int hi, const int G, const int vcu) {
    const int NGW = G * 8; const int bid = (int)blockIdx.x;
#define PHASE_WS() unsigned char* const ws = kargs()->ws
    const size_t SLOT = (size_t)NTOK * 1024;

        const int pb = 1 + l * PH_PER_LAYER;
        const bool moe = (l & 1) != 0;
#define WIN ((const bf16*)(ws + WS_WIN) + (size_t)l * 11264 * D_)

        if (IN(pb + 0)) {
            PHASE_WS();
#ifndef PA_PARTS
#define PA_PARTS 7
#endif
            { pg8::Gemm g{(const bf16*)ws, (const bf16*)ws, D_, D_, D_}; pg8::SchedPA S{G, bid, WS_WIN + (size_t)l * 11264 * D_ * 2, WS_XB, WS_PBP + (size_t)l * NTOK * D_ * 2, WS_WPP + (size_t)l * D_ * D_ * 2};
              pg8::EpiPA E{H5, cosT, sinT, VT, H5 + 2 * SLOT, (long)((WS_RG1 - WS_H5) / 2) - (long)(2 * SLOT), PWB};
              pg8::gemm_phase<pg8::EpiPA, pg8::SchedPA, true>(lds, g, S, E); }
            { pg8::Gemm g{(const bf16*)(ws + WS_XB8), (const bf16*)(ws + WS_WG8 + (size_t)l * 4096 * D_), D_ / 2, D_ / 2, D_ / 2};
              pg8::SchedPlain S{NTOK / 256, 4096 / 256, G, bid, (size_t)256 * D_, (size_t)256 * D_}; pg8::EpiGate8 E{GATES, kargs()->in[6] + (size_t)l * 4096};
              pg8::gemm_phase<pg8::EpiGate8, pg8::SchedPlain, true, true>(lds, g, S, E); }
        }
        SEAM(pb + 0);
        if (IN(pb + 1)) {
            PHASE_WS();
            const bf16 *RQ = H5, *RK = H5 + SLOT, *RG = H5 + 2 * SLOT, *SQ = H5 + 3 * SLOT, *SK = H5 + 4 * SLOT, *RG1 = (const bf16*)(ws + WS_RG1);
            LAS int* uq = (LAS int*)(lds + LDSCTL_OFF + 2048);
            unsigned* qctr = (unsigned*)(ws + WS_CTL) + (size_t)(kargs()->li * DEPTH + l) * 8 * 32;
            const int q0 = bid & 7;
            for (;;) {
                if (tidx() < 64) {
                    const int ln = (int)tidx();
                    const unsigned cnt = (ln < 8) ? xb_ld(qctr + ((q0 + ln) & 7) * 32) : 64u;
                    unsigned long long m = __ballot(cnt < 64u);
                    int got = -1, gq = 0;
                    while (m != 0ull) {
                        const int j = __builtin_ctzll(m); m &= m - 1ull;
                        const int qj = (q0 + j) & 7; unsigned t = 0u;
                        if (ln == 0) t = atomicAdd(qctr + qj * 32, 1u);
                        t = (unsigned)__builtin_amdgcn_readfirstlane((int)t);
                        if (t < 64u) { got = (int)t; gq = qj; break; }
                    }
                    if (ln == 0) { uq[0] = got; uq[1] = gq; }
                }
                __syncthreads();
                const int u = __builtin_amdgcn_readfirstlane(uq[0]), q = __builtin_amdgcn_readfirstlane(uq[1]);
                __syncthreads();
                if (u < 0) break;
                const int code = (int)((0x89ABCDEF01234567ull >> (4 * (u >> 2))) & 15ull);
                const int bh = q * 4 + (u & 3), b = bh >> 3, h = bh & 7, qb = code & 7;
                if (code & 8) att::unit<1>(lds, SQ, SK, VT, RG, RG1, O, b, h, qb);
                else att::unit<0>(lds, RQ, RK, VT, RG, RG1, O, b, h, qb);
            }
        }
        SEAM(pb + 1);
        if (IN(pb + 2)) {
            PHASE_WS();
            pg8::Gemm g{O, (const bf16*)(ws + WS_WBR) + (size_t)l * D_ * D_, D_, D_, D_};
            pg8::SchedPlain S{NTOK / 256, D_ / 256, G, bid, (size_t)256 * D_ * 2, (size_t)256 * D_ * 2}; pg8::EpiMerge E{GATES, MERGED};
            pg8::gemm_phase<pg8::EpiMerge, pg8::SchedPlain, true>(lds, g, S, E);
        }
        SEAM(pb + 2);
        if (IN(pb + 3)) {
            PHASE_WS();
            pg8::Gemm g{MERGED, (const bf16*)(ws + WS_WO) + (size_t)l * D_ * D_, D_, D_, D_};
            pg8::SchedPlain S{NTOK / 256, D_ / 256, G, bid, (size_t)256 * D_ * 2, (size_t)256 * D_ * 2}; pg8::EpiYb<false> E{XB, nullptr, Yb};
            pg8::gemm_phase<pg8::EpiYb<false>, pg8::SchedPlain, true>(lds, g, S, E);
        }
        SEAM(pb + 3);
        if (IN(pb + 4)) {
            PHASE_WS();
            PHASE_IDS();
            const float* g1 = kargs()->in[8] + (size_t)l * D_; const float* b1 = kargs()->in[9] + (size_t)l * D_;
#define LN_PIPE(CALL) do { u32x4 cu_[4], nx_[4]; int row = gw; \
                if (row < NTOK) { const bf16* yr_ = Yb + (size_t)row * D_ + 8 * lane; _Pragma("unroll") for (int j = 0; j < 4; ++j) cu_[j] = *(const u32x4*)(yr_ + 512 * j); } \
                for (; row < NTOK; row += NGW) { const int rn_ = row + NGW; \
                    if (rn_ < NTOK) { const bf16* yr_ = Yb + (size_t)rn_ * D_ + 8 * lane; _Pragma("unroll") for (int j = 0; j < 4; ++j) nx_[j] = *(const u32x4*)(yr_ + 512 * j); } \
                    CALL; \
                    _Pragma("unroll") for (int j = 0; j < 4; ++j) cu_[j] = nx_[j]; } } while (0)
            if (!moe) { LN_PIPE((ln_row<false, false>(row, lane, Yb, g1, b1, nullptr, X1B, nullptr, (const LAS float*)nullptr, nullptr, nullptr, nullptr, nullptr, nullptr, nullptr, cu_))); }
            else { const float* wr = kargs()->in[13] + (size_t)(l / 2) * D_ * NE; LAS float* wT = (LAS float*)lds;
                for (int c = tid; c < D_; c += 512) { const f32x4 a = *(const f32x4*)(wr + (size_t)c * 8), b = *(const f32x4*)(wr + (size_t)c * 8 + 4);
                    LAS float* wp = wT + ((c >> 2) & 1) * 1024 + ((c >> 9) * 64 + ((c >> 3) & 63)) * 4 + (c & 3);
                    wp[0] = a[0]; wp[2048] = a[1]; wp[2 * 2048] = a[2]; wp[3 * 2048] = a[3]; wp[4 * 2048] = b[0]; wp[5 * 2048] = b[1]; wp[6 * 2048] = b[2]; wp[7 * 2048] = b[3]; }
                __syncthreads();
                LN_PIPE((ln_row<true, false>(row, lane, Yb, g1, b1, nullptr, X1B, nullptr, wT, tope, topg, nullptr, nullptr, nullptr, nullptr, cu_)));
                __syncthreads(); }
        }
        SEAM(pb + 4);
        if (IN(pb + 5) && moe) {
            PHASE_WS();
            PHASE_IDS();
            LAS int* cnt = (LAS int*)lds;
            LAS int* tot = (LAS int*)(lds + 16384);
            LAS int* dl = (LAS int*)(lds + 16384 + 64);
            LAS unsigned char* eb = lds + 32768;
            {
                const u32x4* tp = (const u32x4*)(tope + 32 * tid); u32x4 tv[8];
#pragma unroll
                for (int q = 0; q < 8; ++q) tv[q] = tp[q];
                int c0 = 0, c1 = 0, c2 = 0, c3 = 0, c4 = 0, c5 = 0, c6 = 0, c7 = 0;
#pragma unroll
                for (int q = 0; q < 8; ++q) { const unsigned ev[4] = {tv[q].x, tv[q].y, tv[q].z, tv[q].w};
#pragma unroll
                    for (int k = 0; k < 4; ++k) { const unsigned e = ev[k]; c0 += (e == 0u); c1 += (e == 1u); c2 += (e == 2u); c3 += (e == 3u); c4 += (e == 4u); c5 += (e == 5u); c6 += (e == 6u); c7 += (e == 7u); }
                    *(LAS unsigned*)(eb + 32 * tid + 4 * q) = ev[0] | (ev[1] << 8) | (ev[2] << 16) | (ev[3] << 24); }
                LAS int* cr = cnt + tid * 8; cr[0] = c0; cr[1] = c1; cr[2] = c2; cr[3] = c3; cr[4] = c4; cr[5] = c5; cr[6] = c6; cr[7] = c7;
            }
            __syncthreads();
            {
                const int e = wave; int loc[8]; int sum = 0;
#pragma unroll
                for (int q = 0; q < 8; ++q) { loc[q] = cnt[(8 * lane + q) * 8 + e]; sum += loc[q]; }
                int incl = sum;
#pragma unroll
                for (int o = 1; o < 64; o <<= 1) { const int v = __shfl_up(incl, o); if (lane >= o) incl += v; }
                int run = incl - sum;
#pragma unroll
                for (int q = 0; q < 8; ++q) { cnt[(8 * lane + q) * 8 + e] = run; run += loc[q]; }
                if (lane == 63) tot[e] = incl;
            }
            __syncthreads();
            if (tid == 0) { int off = 0, nb = 0; for (int e = 0; e < 8; ++e) { tot[8 + e] = off; const int nbl = (tot[e] + 255) >> 8; if (bid == 0) for (int q = 0; q < nbl; ++q) blk_e[nb + q] = e; nb += nbl; off += nbl * 256; }
                if (bid == 0) { meta[0] = nb; for (int q = nb; q < MOE_P / 256; ++q) blk_e[q] = NE - 1; } }
            __syncthreads();
            for (int sl = vcu; sl < 256; sl += G) {
                if (tid < 64) {
                    const int f = 64 * sl + tid, chunk = f >> 5, j = f & 31; const unsigned e = eb[f]; int rank = 0;
                    for (int jj = 0; jj < j; ++jj) rank += (eb[32 * chunk + jj] == e);
                    const int dest = tot[8 + e] + cnt[chunk * 8 + e] + rank;
                    pos[f] = dest; dl[tid] = dest; dl[64 + tid] = f >> 1;
                }
                __syncthreads();
                for (int r = wave; r < 64; r += 8) { const int dest = dl[r], tk = dl[64 + r];
                    const u32x4* s = (const u32x4*)(X1B + (size_t)tk * D_); u32x2* d = (u32x2*)((unsigned char*)XS + (size_t)dest * D_);
#pragma unroll
                    for (int q = 0; q < 4; ++q) { const u32x4 w = s[lane + 64 * q]; float x[8]; att::unpack8(w, x);
                        d[lane + 64 * q] = (u32x2){pg8::pk4_fp8(x[0] * X_SC, x[1] * X_SC, x[2] * X_SC, x[3] * X_SC), pg8::pk4_fp8(x[4] * X_SC, x[5] * X_SC, x[6] * X_SC, x[7] * X_SC)}; } }
                __syncthreads();
            }
        }
        if (moe) SEAM(pb + 5);
        if (IN(pb + 6)) {
            PHASE_WS();
            if (!moe) { pg8::Gemm g{X1B, (const bf16*)(ws + WS_WF1), D_, D_, D_}; pg8::SchedPlain S{NTOK / 256, 2 * DFF / 256, G, bid, (size_t)256 * D_ * 2, (size_t)256 * D_ * 2}; pg8::EpiSwiB8 E{(unsigned char*)HMID, DFF};
                pg8::gemm_phase<pg8::EpiSwiB8, pg8::SchedPlain, true>(lds, g, S, E); }
            else { const int nblk = __builtin_amdgcn_readfirstlane(meta[0]);
                LAS int* etab = (LAS int*)(lds + LDSCTL_OFF + 1024); if (tidx() < MOE_P / 256) etab[tidx()] = blk_e[tidx()]; __syncthreads();
                pg8::Gemm g{XS, (const bf16*)(ws + WS_WM1), D_ / 2, D_ / 2, D_ / 2}; pg8::SchedMoe S{etab, nblk, 2 * DFFE / 256, G, bid, (size_t)256 * D_, (size_t)256 * D_, (size_t)2 * DFFE * D_};
                pg8::EpiSwi8 E{(unsigned char*)HMID, DFFE};
                pg8::gemm_phase<pg8::EpiSwi8, pg8::SchedMoe, true, true>(lds, g, S, E); }
            if (!moe) { pg8::Gemm g{X1B, (const bf16*)(ws + WS_WG) + (size_t)l * D_ * D_, D_, D_, D_}; pg8::SchedPlain S{NTOK / 256, D_ / 256, G, bid, (size_t)256 * D_ * 2, (size_t)256 * D_ * 2}; pg8::EpiPleB E{PWB, PLEB};
              pg8::gemm_phase<pg8::EpiPleB, pg8::SchedPlain, true>(lds, g, S, E); }
        }
        SEAM(pb + 6);
        if (IN(pb + 7)) {
            PHASE_WS();
            if (!moe) { LAS int* etab = (LAS int*)(lds + LDSCTL_OFF + 1024); if (tidx() < MOE_P / 256) etab[tidx()] = 0; __syncthreads();
                pg8::Gemm g{HMID, (const bf16*)(ws + WS_WF2), DFF / 2, DFF / 2, DFF / 2}; pg8::SchedMoe S{etab, NTOK / 256, D_ / 256, G, bid, (size_t)256 * DFF, (size_t)256 * DFF, (size_t)0}; pg8::EpiYb8 E{X1B, PLEB, Yb};
                pg8::gemm_phase<pg8::EpiYb8, pg8::SchedMoe, true, true>(lds, g, S, E); }
            else { const int nblk = __builtin_amdgcn_readfirstlane(meta[0]);
                LAS int* etab = (LAS int*)(lds + LDSCTL_OFF + 1024); if (tidx() < MOE_P / 256) etab[tidx()] = blk_e[tidx()]; __syncthreads();
                { pg8::Gemm g{HMID, (const bf16*)(ws + WS_WM2), DFFE / 2, DFFE / 2, DFFE / 2};
                  pg8::SchedMoe S{etab, nblk, D_ / 256, G, bid, (size_t)256 * DFFE, (size_t)256 * DFFE, (size_t)D_ * DFFE}; pg8::EpiYE2 E{YE2};
                  pg8::gemm_phase<pg8::EpiYE2, pg8::SchedMoe, true, true>(lds, g, S, E); }
                { const int r0 = (nblk * 8) % G;
                  pg8::Gemm g{X1B, (const bf16*)(ws + WS_WG) + (size_t)l * D_ * D_, D_, D_, D_}; pg8::SchedTail S{NTOK / 256, D_ / 256, G, bid, r0, (size_t)256 * D_ * 2, (size_t)256 * D_ * 2}; pg8::EpiPleB E{PWB, PLEB};
                  pg8::gemm_phase<pg8::EpiPleB, pg8::SchedTail, true>(lds, g, S, E); } }
        }
        SEAM(pb + 7);
        if (IN(pb + 8)) {
            PHASE_WS();
            PHASE_IDS();
            const float* g2 = kargs()->in[19] + (size_t)l * D_; const float* b2 = kargs()->in[20] + (size_t)l * D_;
            float* const xout_ = (l == DEPTH - 1) ? kargs()->out : (float*)nullptr;
            bf16* const xb_ = (l == DEPTH - 1) ? (bf16*)nullptr : XB; unsigned char* const xb8_ = (l == DEPTH - 1) ? (unsigned char*)nullptr : (unsigned char*)(ws + WS_XB8);
            if (!moe) { LN_PIPE((ln_row<false, false>(row, lane, Yb, g2, b2, xout_, xb_, xb8_, (const LAS float*)nullptr, nullptr, nullptr, nullptr, nullptr, nullptr, nullptr, cu_))); }
            else { for (int row = gw; row < NTOK; row += NGW) ln_row<false, true>(row, lane, nullptr, g2, b2, xout_, xb_, xb8_, (const LAS float*)nullptr, nullptr, topg, X1B, YE2, pos, PLEB); }
        }
        SEAM(pb + 8);
    }

#undef cosT
#undef sinT
#undef XB
#undef PB
#undef H5
#undef VT
#undef GATES
#undef O
#undef T1
#undef MERGED
#undef Yb
#undef X1B
#undef PLEB
#undef PWB
#undef HMID
#undef XS
#undef YE2
#undef tope
#undef topg
#undef pos
#undef blk_e
#undef meta
#undef WIN
#undef PHASE_WS
__global__ void __launch_bounds__(512, 2) mk_fwd(FArgs args) {
    extern __shared__ __attribute__((aligned(16))) unsigned char lds_raw[];
    LAS unsigned char* lds = (LAS unsigned char*)lds_raw;
    volatile LAS unsigned* MISC = (volatile LAS unsigned*)(lds + MISC_OFF);
    const int G = gridDim.x; int vcu; { const int bx = blockIdx.x; vcu = (G % 8 == 0) ? (bx % 8) * (G / 8) + bx / 8 : bx; }
    unsigned char* const ws = kargs()->ws;
    unsigned* ctl = (unsigned*)(ws + WS_CTL);
    for (int u = threadIdx.x; u < (LDS_BYTES - LDSCTL_OFF) / 4; u += 512) ((LAS unsigned*)(lds + LDSCTL_OFF))[u] = 0u;
    __syncthreads();
    if ((threadIdx.x & 63) == 0) ((LAS int*)(131072 + 3072))[hw_wave_slot()] = (int)(threadIdx.x >> 6);
    __syncthreads();
    XcdBarrier bar = xcd_barrier_post(ctl + CW_BAR + kargs()->li * XCD_BAR_WORDS, MISC + 8);
    const int lo = kargs()->ph_lo, hi = kargs()->ph_hi;
    const int NGW = G * 8;
    const int bid = (int)blockIdx.x;

    float* cosT = (float*)(ws + WS_ROT); float* sinT = cosT + S_ * 64;
    bf16* XB = (bf16*)(ws + WS_XB); bf16* PB = (bf16*)(ws + WS_PB); bf16* H5 = (bf16*)(ws + WS_H5); bf16* VT = (bf16*)(ws + WS_VT); bf16* GATES = (bf16*)(ws + WS_GATES);
    bf16* O = (bf16*)(ws + WS_O); float* T1 = (float*)(ws + WS_T1); bf16* MERGED = (bf16*)(ws + WS_MERGED); float* Y = (float*)(ws + WS_Y); float* X1 = (float*)(ws + WS_X1);
    bf16* X1B = (bf16*)(ws + WS_X1B); float* X2 = (float*)(ws + WS_X2); float* PLE = (float*)(ws + WS_PLE); float* PW = (float*)(ws + WS_PW); bf16* HMID = (bf16*)(ws + WS_HMID);
    bf16* XS = (bf16*)(ws + WS_XS); bf16* YE2 = (bf16*)(ws + WS_XS);
    int* tope = (int*)(ws + WS_MOE + MO_TOPE); float* topg = (float*)(ws + WS_MOE + MO_TOPG); int* pos = (int*)(ws + WS_MOE + MO_POS);
    int* blk_e = (int*)(ws + WS_MOE + MO_BLKE); int* meta = (int*)(ws + WS_MOE + MO_META);
    const size_t SLOT = (size_t)NTOK * 1024;

    if (IN(0)) {
        PHASE_IDS();
        LAS unsigned* T = (LAS unsigned*)(lds + wave * 16384);
        int rot = 0;
        for (int l = 0; l < DEPTH; ++l) {
            bf16* WIN = (bf16*)(ws + WS_WIN) + (size_t)l * 11264 * D_;
            cvt_seg(CvtSeg{kargs()->in[2] + (size_t)l * D_ * INW, WIN, 1, D_, INW, 2048, 3, D_, 0}, rot, gw, NGW, T, lane);
            cvt_seg(CvtSeg{kargs()->in[2] + (size_t)l * D_ * INW + 2048, WIN + (size_t)2048 * D_, 1, D_, INW, INW - 2048, 0, D_, 0}, rot, gw, NGW, T, lane);
            cvt_seg8(CvtSeg{kargs()->in[5] + (size_t)l * D_ * 4096, (bf16*)(ws + WS_WG8 + (size_t)l * 4096 * D_), 1, D_, 4096, 4096, 0, D_, 0}, W13_SC, rot, gw, NGW, T, lane);
            cvt_seg(CvtSeg{kargs()->in[3] + (size_t)l * RW * D_, (bf16*)(ws + WS_WBR) + (size_t)l * D_ * D_, 1, RW, D_, D_, 0, D_, 0}, rot, gw, NGW, T, lane);
            cvt_seg(CvtSeg{kargs()->in[4] + (size_t)l * RW * D_, (bf16*)(ws + WS_WBR) + (size_t)l * D_ * D_, 1, RW, D_, D_, 0, D_, RW}, rot, gw, NGW, T, lane);
            cvt_seg(CvtSeg{kargs()->in[7] + (size_t)l * D_ * D_, (bf16*)(ws + WS_WO) + (size_t)l * D_ * D_, 1, D_, D_, D_, 0, D_, 0}, rot, gw, NGW, T, lane);
            cvt_seg(CvtSeg{kargs()->in[17] + (size_t)l * PLED * D_, (bf16*)(ws + WS_WPP) + (size_t)l * D_ * D_, 1, PLED, D_, D_, 0, D_, 0}, rot, gw, NGW, T, lane);
            cvt_seg(CvtSeg{kargs()->in[18] + (size_t)l * D_ * D_, (bf16*)(ws + WS_WG) + (size_t)l * D_ * D_, 1, D_, D_, D_, 0, D_, 0}, rot, gw, NGW, T, lane);
        }
        cvt_seg(CvtSeg{kargs()->in[10], (bf16*)(ws + WS_WF1), 1, D_, DFF, DFF, 1, D_, 0}, rot, gw, NGW, T, lane);
        cvt_seg(CvtSeg{kargs()->in[11], (bf16*)(ws + WS_WF1), 1, D_, DFF, DFF, 2, D_, 0}, rot, gw, NGW, T, lane);
        cvt_seg8(CvtSeg{kargs()->in[12], (bf16*)(ws + WS_WF2), 1, DFF, D_, D_, 0, DFF, 0}, W2_SC, rot, gw, NGW, T, lane);
        cvt_seg8(CvtSeg{kargs()->in[14], (bf16*)(ws + WS_WM1), NE, D_, DFFE, DFFE, 1, D_, 0}, W13_SC, rot, gw, NGW, T, lane);
        cvt_seg8(CvtSeg{kargs()->in[15], (bf16*)(ws + WS_WM1), NE, D_, DFFE, DFFE, 2, D_, 0}, W13_SC, rot, gw, NGW, T, lane);
        cvt_seg8(CvtSeg{kargs()->in[16], (bf16*)(ws + WS_WM2), NE, DFFE, D_, D_, 0, DFFE, 0}, W2_SC, rot, gw, NGW, T, lane);
        { const size_t n4 = (size_t)NTOK * D_ / 4; const f32x4* s = (const f32x4*)kargs()->in[0]; u32x2* d = (u32x2*)XB;
          unsigned* d8 = (unsigned*)(ws + WS_XB8);
          for (size_t i = (size_t)bid * 512 + tid; i < n4; i += (size_t)G * 512) { const f32x4 v = s[i]; d[i] = (u32x2){pg8::cvt_pk_bf16(v.x, v.y), pg8::cvt_pk_bf16(v.z, v.w)}; d8[i] = pg8::pk4_fp8(v.x * X_SC, v.y * X_SC, v.z * X_SC, v.w * X_SC); } }
        { const size_t n4 = (size_t)DEPTH * NTOK * PLED / 4; const f32x4* s = (const f32x4*)kargs()->in[1]; u32x2* d = (u32x2*)(ws + WS_PBP);
          for (size_t i = (size_t)bid * 512 + tid; i < n4; i += (size_t)G * 512) { const f32x4 v = s[i]; d[(i >> 6) * (D_ / 4) + (i & 63)] = (u32x2){pg8::cvt_pk_bf16(v.x, v.y), pg8::cvt_pk_bf16(v.z, v.w)}; } }
        for (int i = bid * 512 + tid; i < S_ * 64; i += G * 512) {
            const int pos_ = i >> 6, d = i & 63; const double rr = 0.86596432336006535; double inv = 1.0; for (int k = 0; k < d; ++k) inv *= rr;
            const double ang = (double)pos_ * inv; const double twopi = 6.283185307179586476925; const double x = ang - twopi * __builtin_rint(ang / twopi);
            double s, c; sincos_small(x * 0.25, s, c); const double s2 = 2.0 * s * c, c2 = c * c - s * s; cosT[i] = (float)(c2 * c2 - s2 * s2); sinT[i] = (float)(2.0 * s2 * c2);
        }
        __syncthreads();
    }
    SEAM(0);

    layer_body<0>(lds, bar, lo, hi, G, vcu);
    layer_body<1>(lds, bar, lo, hi, G, vcu);
#undef IN
#undef SEAM
}
extern "C" void kernel_launch(void* const* d_in, const int* in_sizes, int n_in, void* d_out, int out_size, void* d_ws, size_t ws_size, hipStream_t stream) {
    static int grid = 0;
    if (grid == 0) {
        if (n_in != 21 || ws_size < WS_END || out_size != NTOK * D_) { fprintf(stderr, "kernel_launch: unexpected n_in %d / out_size %d / ws_size %zu (need %zu)\n", n_in, out_size, ws_size, (size_t)WS_END); grid = -1; return; }
        int dev = 0, cus = 0, per_cu = 0;
        if (hipGetDevice(&dev) != hipSuccess || hipDeviceGetAttribute(&cus, hipDeviceAttributeMultiprocessorCount, dev) != hipSuccess) { grid = -1; return; }
        if (hipFuncSetAttribute((const void*)mk_fwd, hipFuncAttributeMaxDynamicSharedMemorySize, LDS_BYTES) != hipSuccess) { fprintf(stderr, "kernel_launch: hipFuncSetAttribute failed\n"); grid = -1; return; }
        if (hipOccupancyMaxActiveBlocksPerMultiprocessor(&per_cu, (const void*)mk_fwd, 512, LDS_BYTES) != hipSuccess || per_cu < 1) { fprintf(stderr, "kernel_launch: occupancy query says %d blocks/CU\n", per_cu); (void)hipGetLastError(); per_cu = 1; }
        grid = cus;
    }
    if (grid < 0) return;
    unsigned char* ws = (unsigned char*)d_ws;
    (void)hipMemsetAsync(ws + WS_CTL, 0, 1 * MiB, stream);
    FArgs fa{};
    for (int i = 0; i < 21; ++i) fa.in[i] = (const float*)d_in[i];
    fa.out = (float*)d_out; fa.ws = ws; fa.pad = 0;
#ifdef PROBE_DUP
    fa.ph_lo = 0; fa.ph_hi = PROBE_DUP + 1; fa.li = 0; hipLaunchKernelGGL(mk_fwd, dim3(grid), dim3(512), LDS_BYTES, stream, fa);
    fa.ph_lo = PROBE_DUP; fa.ph_hi = N_PHASES; fa.li = 1; hipLaunchKernelGGL(mk_fwd, dim3(grid), dim3(512), LDS_BYTES, stream, fa);
    return;
#endif
    fa.ph_lo = 0; fa.ph_hi = N_PHASES; fa.li = 0;
    hipLaunchKernelGGL(mk_fwd, dim3(grid), dim3(512), LDS_BYTES, stream, fa);
}
```
